# Optimizing an MI355X kernel written in HIP

```python
import jax, jax.numpy as jnp
from jax import lax
import numpy as np

D_MODEL = 2048
BATCH = 4
SEQ = 4096
DEPTH = 1

PLE_DIM = 256
M_HEADS = 4
M_QK_DIM = 128
M_V_DIM = 256
M_QK = M_HEADS * M_QK_DIM
M_V = M_HEADS * M_V_DIM
CONV_W = 4
CHUNK = 128
POOL_WINDOWS = (2, 4, 8, 16)
POOL_GROUPS = 4
POOL_GROUP_DIM = 256
POOL_W = POOL_GROUPS * POOL_GROUP_DIM
IN_SPLITS = (2 * M_QK, M_V, M_V, M_HEADS, M_HEADS, POOL_W, D_MODEL, D_MODEL)
IN_DIM = sum(IN_SPLITS)
IN_OFFSETS = tuple(int(s) for s in np.cumsum(IN_SPLITS)[:-1])
F_GATE_OFF = 2 * M_QK + 2 * M_V + M_HEADS
N_GROUPS = 4
EXPERTS_PER_GROUP = 8
N_EXPERTS = N_GROUPS * EXPERTS_PER_GROUP
TOP_K = 2
D_EXPERT = 768
MOE_BLOCK = 128
ALPHA = (2 * DEPTH) ** 0.25
BETA = (8 * DEPTH) ** -0.25
LN_EPS = 1e-5

kernel_name = 'hybrid_mlstm_pool_hmoe_deepnorm'


def layer_norm(x, g, b):
    xf = x.astype(jnp.float32)
    mu = xf.mean(-1, keepdims=True)
    var = jnp.square(xf - mu).mean(-1, keepdims=True)
    return ((xf - mu) * lax.rsqrt(var + LN_EPS) * g + b).astype(x.dtype)


def causal_dwconv(u, w, b):
    S = u.shape[1]
    up = jnp.pad(u, ((0, 0), (CONV_W - 1, 0), (0, 0)))
    out = b + up[:, 0:S] * w[0]
    for tap in range(1, CONV_W):
        out = out + up[:, tap:tap + S] * w[tap]
    return out


def mlstm_chunkwise(q, k, v, ig, fg):
    B, S, H, _ = q.shape
    nc = S // CHUNK
    f32 = jnp.float32

    def to_chunks(a):
        a = a.astype(f32).reshape((B, nc, CHUNK, H) + a.shape[3:])
        return jnp.moveaxis(a, (1, 3), (0, 2))

    qc = to_chunks(q)
    kc = to_chunks(k) * (M_QK_DIM ** -0.5)
    vc = to_chunks(v)
    lfc = jax.nn.log_sigmoid(to_chunks(fg))
    igc = to_chunks(ig)
    causal = jnp.tril(jnp.ones((CHUNK, CHUNK), bool))

    def step(carry, inp):
        C, n, m = carry
        qb, kb, vb, lf, ib = inp
        b = jnp.cumsum(lf, axis=-1)
        dmat = jnp.where(causal, b[..., :, None] - b[..., None, :] + ib[..., None, :], -jnp.inf)
        inter = b + m[..., None]
        m_row = jnp.maximum(inter, dmat.max(-1))
        s = jnp.einsum('bhjd,bhld->bhjl', qb, kb) * jnp.exp(dmat - m_row[..., None])
        scale_prev = jnp.exp(inter - m_row)
        num = jnp.einsum('bhjl,bhlv->bhjv', s, vb) + scale_prev[..., None] * jnp.einsum('bhvd,bhjd->bhjv', C, qb)
        den = s.sum(-1) + scale_prev * jnp.einsum('bhd,bhjd->bhj', n, qb)
        h = num / jnp.maximum(jnp.abs(den), jnp.exp(-m_row))[..., None]
        b_last = b[..., -1]
        g = b_last[..., None] - b + ib
        m_new = jnp.maximum(b_last + m, g.max(-1))
        w = jnp.exp(g - m_new[..., None])
        decay = jnp.exp(b_last + m - m_new)
        C = decay[..., None, None] * C + jnp.einsum('bhl,bhlv,bhld->bhvd', w, vb, kb)
        n = decay[..., None] * n + jnp.einsum('bhl,bhld->bhd', w, kb)
        return (C, n, m_new), h

    init = (jnp.zeros((B, H, M_V_DIM, M_QK_DIM), f32), jnp.zeros((B, H, M_QK_DIM), f32), jnp.zeros((B, H), f32))
    _, hs = lax.scan(step, init, (qc, kc, vc, lfc, igc))
    return jnp.moveaxis(hs, (0, 2), (1, 3)).reshape(B, S, H, M_V_DIM)


def multiscale_pool(u):
    S = u.shape[1]
    uf = u.astype(jnp.float32)
    cs = jnp.pad(jnp.cumsum(uf, axis=1), ((0, 0), (1, 0), (0, 0)))
    t = jnp.arange(S)
    outs = []
    for g, win in enumerate(POOL_WINDOWS):
        sl = slice(g * POOL_GROUP_DIM, (g + 1) * POOL_GROUP_DIM)
        c = cs[:, :, sl]
        lo = jnp.maximum(t + 1 - win, 0)
        cnt = jnp.minimum(t + 1, win).astype(jnp.float32)
        outs.append((c[:, 1:] - c[:, lo]) / cnt[None, :, None] - uf[:, :, sl])
    return jnp.concatenate(outs, axis=-1).astype(u.dtype)


def token_mixer(x, w_in, b_in, conv_w, conv_b, mh_g, w_pool, pool_scale, w_m_br, w_p_br, w_out):
    B, S, _ = x.shape
    z = x @ w_in + b_in
    qk_pre, v, o, ig, fg, u, gm, gp = jnp.split(z, IN_OFFSETS, axis=-1)
    qk = jax.nn.silu(causal_dwconv(qk_pre, conv_w, conv_b))
    q, k = jnp.split(qk, [M_QK], axis=-1)
    h = mlstm_chunkwise(q.reshape(B, S, M_HEADS, M_QK_DIM), k.reshape(B, S, M_HEADS, M_QK_DIM),
                        v.reshape(B, S, M_HEADS, M_V_DIM), ig, fg)
    mu = h.mean(-1, keepdims=True)
    var = jnp.square(h - mu).mean(-1, keepdims=True)
    h = (h - mu) * lax.rsqrt(var + LN_EPS) * mh_g.reshape(M_HEADS, M_V_DIM)
    h = h.reshape(B, S, M_V).astype(x.dtype) * jax.nn.sigmoid(o)
    a = h @ w_m_br
    y = multiscale_pool(u).reshape(B, S, POOL_GROUPS, POOL_GROUP_DIM)
    y = jnp.einsum('bsgc,gcd->bsgd', y, w_pool).reshape(B, S, POOL_W) * pool_scale
    pb = y @ w_p_br
    merged = jax.nn.sigmoid(gm) * a + jax.nn.sigmoid(gp) * pb
    return merged @ w_out


def hier_moe(x, w_rg, b_rg, w_re, b_re, w_gate, w_up, w_down):
    B, S, D = x.shape
    T = B * S
    xf = x.reshape(T, D)
    pg = jax.nn.softmax((xf @ w_rg + b_rg).astype(jnp.float32), axis=-1)
    pg_top, g_idx = lax.top_k(pg, 1)
    le = (xf @ w_re + b_re).astype(jnp.float32).reshape(T, N_GROUPS, EXPERTS_PER_GROUP)
    le_sel = jnp.take_along_axis(le, g_idx[:, :, None], axis=1)[:, 0]
    pe = jax.nn.softmax(le_sel, axis=-1)
    pe_top, e_local = lax.top_k(pe, TOP_K)
    gate = pg_top * pe_top / pe_top.sum(-1, keepdims=True)
    e_idx = g_idx * EXPERTS_PER_GROUP + e_local
    A = T * TOP_K
    flat_e = e_idx.reshape(A)
    flat_tok = jnp.repeat(jnp.arange(T, dtype=jnp.int32), TOP_K)
    flat_w = gate.reshape(A)
    order = jnp.argsort(flat_e)
    se, stok, sw = flat_e[order], flat_tok[order], flat_w[order]
    counts = jnp.bincount(flat_e, length=N_EXPERTS)
    starts = jnp.cumsum(counts) - counts
    pcounts = (counts + MOE_BLOCK - 1) // MOE_BLOCK * MOE_BLOCK
    pends = jnp.cumsum(pcounts)
    pstarts = pends - pcounts
    dest = pstarts[se] + jnp.arange(A) - starts[se]
    P = A + N_EXPERTS * MOE_BLOCK
    NB = P // MOE_BLOCK
    slot_tok = jnp.zeros((P,), jnp.int32).at[dest].set(stok)
    slot_w = jnp.zeros((P,), jnp.float32).at[dest].set(sw)
    block_e = jnp.minimum(jnp.searchsorted(pends, jnp.arange(NB) * MOE_BLOCK, side='right'), N_EXPERTS - 1)
    xb = xf[slot_tok].reshape(NB, MOE_BLOCK, D)

    def expert_block(args):
        xblk, e = args
        hid = jax.nn.silu(xblk @ w_gate[e]) * (xblk @ w_up[e])
        return hid @ w_down[e]

    yb = lax.map(expert_block, (xb, block_e)).reshape(P, D)
    yb = yb * slot_w[:, None].astype(yb.dtype)
    out = jnp.zeros((T, D), yb.dtype).at[slot_tok].add(yb)
    return out.reshape(B, S, D)


def setup_inputs(seed: int = 0) -> dict:
    key = jax.random.key(seed)
    ks = jax.random.split(key, 32)

    def nrm(k, shape, scale):
        return scale * jax.random.normal(k, shape, jnp.float32)

    sd = D_MODEL ** -0.5
    x = nrm(ks[0], (BATCH, SEQ, D_MODEL), 1.0)
    p = nrm(ks[1], (DEPTH, BATCH, SEQ, PLE_DIM), 1.0)
    w_in = jnp.concatenate([
        nrm(ks[2], (DEPTH, D_MODEL, 2 * M_QK), sd),
        nrm(ks[3], (DEPTH, D_MODEL, M_V), sd * BETA),
        nrm(ks[4], (DEPTH, D_MODEL, M_V), sd),
        nrm(ks[5], (DEPTH, D_MODEL, 2 * M_HEADS), sd),
        nrm(ks[6], (DEPTH, D_MODEL, POOL_W), sd),
        nrm(ks[7], (DEPTH, D_MODEL, 2 * D_MODEL), sd)], axis=-1)
    f_bias = jnp.broadcast_to(jnp.linspace(3.0, 6.0, M_HEADS, dtype=jnp.float32), (DEPTH, M_HEADS))
    b_in = nrm(ks[8], (DEPTH, IN_DIM), 0.02).at[:, F_GATE_OFF:F_GATE_OFF + M_HEADS].add(f_bias)
    conv_w = nrm(ks[9], (DEPTH, CONV_W, 2 * M_QK), CONV_W ** -0.5)
    conv_b = nrm(ks[10], (DEPTH, 2 * M_QK), 0.02)
    mh_g = 1.0 + nrm(ks[11], (DEPTH, M_V), 0.02)
    w_pool = nrm(ks[12], (DEPTH, POOL_GROUPS, POOL_GROUP_DIM, POOL_GROUP_DIM), POOL_GROUP_DIM ** -0.5)
    pool_scale = 1.0 + nrm(ks[13], (DEPTH, POOL_W), 0.1)
    w_m_br = nrm(ks[14], (DEPTH, M_V, D_MODEL), M_V ** -0.5)
    w_p_br = nrm(ks[15], (DEPTH, POOL_W, D_MODEL), POOL_W ** -0.5)
    w_out = nrm(ks[16], (DEPTH, D_MODEL, D_MODEL), sd * BETA)
    ln1_g = 1.0 + nrm(ks[17], (DEPTH, D_MODEL), 0.02)
    ln1_b = nrm(ks[18], (DEPTH, D_MODEL), 0.02)
    w_rg = nrm(ks[19], (DEPTH, D_MODEL, N_GROUPS), sd)
    b_rg = nrm(ks[20], (DEPTH, N_GROUPS), 0.01)
    w_re = nrm(ks[21], (DEPTH, D_MODEL, N_EXPERTS), sd)
    b_re = nrm(ks[22], (DEPTH, N_EXPERTS), 0.01)
    w_gate = nrm(ks[23], (DEPTH, N_EXPERTS, D_MODEL, D_EXPERT), sd)
    w_up = nrm(ks[24], (DEPTH, N_EXPERTS, D_MODEL, D_EXPERT), sd)
    w_down = nrm(ks[25], (DEPTH, N_EXPERTS, D_EXPERT, D_MODEL), (D_EXPERT ** -0.5) * BETA)
    ln2_g = 1.0 + nrm(ks[26], (DEPTH, D_MODEL), 0.02)
    ln2_b = nrm(ks[27], (DEPTH, D_MODEL), 0.02)
    w_ple_gate = nrm(ks[28], (DEPTH, D_MODEL, D_MODEL), sd)
    b_ple_gate = nrm(ks[29], (DEPTH, D_MODEL), 0.02)
    w_ple_proj = nrm(ks[30], (DEPTH, PLE_DIM, D_MODEL), (PLE_DIM ** -0.5) * BETA)
    return {'x': x, 'p': p, 'w_in': w_in, 'b_in': b_in, 'conv_w': conv_w, 'conv_b': conv_b,
            'mh_g': mh_g, 'w_pool': w_pool, 'pool_scale': pool_scale, 'w_m_br': w_m_br,
            'w_p_br': w_p_br, 'w_out': w_out, 'ln1_g': ln1_g, 'ln1_b': ln1_b, 'w_rg': w_rg,
            'b_rg': b_rg, 'w_re': w_re, 'b_re': b_re, 'w_gate': w_gate, 'w_up': w_up,
            'w_down': w_down, 'ln2_g': ln2_g, 'ln2_b': ln2_b, 'w_ple_gate': w_ple_gate,
            'b_ple_gate': b_ple_gate, 'w_ple_proj': w_ple_proj}


def reference(x, p, w_in, b_in, conv_w, conv_b, mh_g, w_pool, pool_scale, w_m_br, w_p_br, w_out,
              ln1_g, ln1_b, w_rg, b_rg, w_re, b_re, w_gate, w_up, w_down, ln2_g, ln2_b,
              w_ple_gate, b_ple_gate, w_ple_proj):
    for i in range(DEPTH):
        h = token_mixer(x, w_in[i], b_in[i], conv_w[i], conv_b[i], mh_g[i], w_pool[i], pool_scale[i],
                        w_m_br[i], w_p_br[i], w_out[i])
        x = layer_norm(ALPHA * x + h, ln1_g[i], ln1_b[i])
        h = hier_moe(x, w_rg[i], b_rg[i], w_re[i], b_re[i], w_gate[i], w_up[i], w_down[i])
        x = layer_norm(ALPHA * x + h, ln2_g[i], ln2_b[i])
        x = x + jax.nn.sigmoid(x @ w_ple_gate[i] + b_ple_gate[i]) * (p[i] @ w_ple_proj[i])
    return x
```

```cpp
#include <hip/hip_runtime.h>
#include <cstdio>
#include <cstdint>

#ifndef MK_N_LAUNCHES
#define MK_N_LAUNCHES 1
#endif

#define GAS __attribute__((address_space(1)))
#define LAS __attribute__((address_space(3)))
typedef unsigned short bf16_t;
typedef short bf16x8 __attribute__((ext_vector_type(8)));
typedef short s16x4 __attribute__((ext_vector_type(4)));
typedef float f32x4 __attribute__((ext_vector_type(4)));
typedef float f32x2 __attribute__((ext_vector_type(2)));
typedef unsigned u32x4 __attribute__((ext_vector_type(4)));
typedef unsigned u32x2 __attribute__((ext_vector_type(2)));

constexpr int D_MODEL = 2048, BATCH = 4, SEQ = 4096, T_TOK = BATCH * SEQ;
constexpr int PLE_DIM = 256, M_HEADS = 4, M_QK_DIM = 128, M_V_DIM = 256, M_QK = 512, M_V = 1024, CHUNK = 128, NCHUNK = SEQ / CHUNK;
constexpr int POOL_W = 1024, IN_DIM = 8200, ZW = 8192;
constexpr int N_EXPERTS = 32, EPG = 8, D_EXPERT = 768, NBH = BATCH * M_HEADS;
constexpr float LN_EPS = 1e-5f;
constexpr float ALPHA = 1.189207115002721f;
constexpr int ZC_QK = 0, ZC_V = 1024, ZC_O = 2048, ZC_U = 3072, ZC_GM = 4096, ZC_GP = 6144;

constexpr size_t MiB = 1u << 20;
constexpr size_t WS_CTL = 0, CTL_ZERO_BYTES = 1 * MiB;
constexpr size_t WS_SMALL = 1 * MiB;
constexpr size_t WS_W = 16 * MiB;
constexpr size_t W_IN = WS_W;
constexpr size_t W_EFF = W_IN + 32 * MiB;
constexpr size_t W_MBR = W_EFF + 4 * MiB;
constexpr size_t W_OUT = W_MBR + 4 * MiB;
constexpr size_t W_PG = W_OUT + 8 * MiB;
constexpr size_t W_PP = W_PG + 8 * MiB;
constexpr size_t W_RT = W_PP + 1 * MiB;
constexpr size_t W_GU = W_RT + 1 * MiB;
constexpr size_t W_DN = W_GU + 192 * MiB;
constexpr size_t WS_PB = W_DN + 96 * MiB;
constexpr size_t WS_Z = WS_PB + 8 * MiB;
constexpr size_t WS_S2 = WS_Z + 256 * MiB;
constexpr size_t WS_END = WS_S2 + 128 * MiB;
constexpr size_t S2_DKV = WS_S2, S2_CST = WS_S2 + 72 * MiB;
constexpr size_t S2_PARK = WS_S2, S2_MERGED = WS_S2 + 64 * MiB;
constexpr size_t S2_X1B = WS_S2, S2_HID = WS_S2 + 64 * MiB;
constexpr size_t S2_X2B = WS_S2, S2_PARK2 = WS_S2 + 64 * MiB;
constexpr size_t Z_X1 = WS_Z, Z_Y = WS_Z + 128 * MiB;
constexpr size_t OUT_XB = 0, OUT_PU = 64 * MiB, OUT_HG = 96 * MiB;
constexpr size_t SM_GATES = 0;
constexpr size_t SM_AT = 1 * MiB;
constexpr size_t SM_MR = SM_AT + 256 * 1024;
constexpr size_t SM_EM = SM_MR + 256 * 1024;
constexpr size_t SM_MC = SM_EM + 256 * 1024;
constexpr size_t SM_ML = SM_MC + 4096;
constexpr size_t SM_DEC = SM_ML + 4096;
constexpr size_t SM_GW = 2 * MiB;
constexpr size_t SM_TL = 3 * MiB;
constexpr int TL_CAP = 32768;
static_assert(SM_TL + 4 * MiB <= 15 * MiB, "small region");
constexpr int CW_BAR = 4096;
constexpr int CW_CNT = 16384;

constexpr int RING_BYTES = 131072;
constexpr int LDS_BYTES = 147456;
constexpr int LDS_MISC_OFF = LDS_BYTES - 256;
constexpr int LDS_USABLE = LDS_MISC_OFF;

constexpr int NWAVES = 8, NTHREADS = 512;

#define RLX_AGENT __ATOMIC_RELAXED, __HIP_MEMORY_SCOPE_AGENT
__device__ __forceinline__ unsigned cvt_pk_bf16(float lo, float hi) { unsigned r; asm volatile("v_cvt_pk_bf16_f32 %0, %1, %2" : "=v"(r) : "v"(lo), "v"(hi)); return r; }
__device__ __forceinline__ float bf_lo(unsigned w) { return __uint_as_float(w << 16); }
__device__ __forceinline__ float bf_hi(unsigned w) { return __uint_as_float(w & 0xffff0000u); }
__device__ __forceinline__ float bf2f(bf16_t h) { return __uint_as_float(((unsigned)h) << 16); }
__device__ __forceinline__ float fast_exp(float x) { return __builtin_amdgcn_exp2f(x * 1.44269504088896f); }
__device__ __forceinline__ float sigmoidf_(float x) { return __builtin_amdgcn_rcpf(1.0f + fast_exp(-x)); }
__device__ __forceinline__ float wave_sum(float v) {
#pragma unroll
    for (int o = 1; o < 64; o <<= 1) v += __shfl_xor(v, o);
    return v;
}

#define XB_TMO      128
#define XB_XCNT(j)  (256  + 64 * (j))
#define XB_XSUB(j)  (1280 + 64 * (j))
#define XB_XGEN(j)  (2304 + 64 * (j))
#define XB_TOP      3328
#define XB_TOPGEN   3392
#define XCD_BAR_WORDS 3456
#define XB_SPIN_CAP (1u << 20)
__device__ __forceinline__ unsigned xb_ld(unsigned* p)              { return __hip_atomic_load(p, __ATOMIC_RELAXED, __HIP_MEMORY_SCOPE_AGENT); }
__device__ __forceinline__ unsigned xb_add(unsigned* p, unsigned v) { return __hip_atomic_fetch_add(p, v, __ATOMIC_RELAXED, __HIP_MEMORY_SCOPE_AGENT); }
__device__ __forceinline__ unsigned xb_xcc_id() { return (unsigned)__builtin_amdgcn_s_getreg((3 << 11) | 20) & 0xFu; }
#define XB_SPIN(cond, bar) do { unsigned _sp = 0; while (cond) { __builtin_amdgcn_s_sleep(1); \
    if ((++_sp & 255u) == 0u) { if (xb_ld(&(bar)[XB_TMO])) break; if (_sp > XB_SPIN_CAP) { atomicAdd(&(bar)[XB_TMO], 1u); break; } } } } while (0)
struct XcdBarrier { unsigned* bar; unsigned x; volatile LAS unsigned* st; };
__device__ __forceinline__ XcdBarrier xcd_barrier_post(unsigned* bar, volatile LAS unsigned* st) {
    XcdBarrier b; b.bar = bar; b.x = xb_xcc_id(); b.st = st;
    if (threadIdx.x == 0) (void)xb_add(&bar[XB_XCNT(b.x)], 1u);
    return b;
}
__device__ __forceinline__ void xcd_barrier_complete(unsigned* bar, unsigned x, unsigned& nloc, unsigned& nx) {
    const unsigned G = gridDim.x * gridDim.y * gridDim.z;
    unsigned sum, cnt, mine, sp = 0u;
    for (;;) {
        sum = 0u; cnt = 0u; mine = 0u;
#pragma unroll
        for (unsigned j = 0; j < 16; ++j) { const unsigned c = xb_ld(&bar[XB_XCNT(j)]); sum += c; cnt += (c > 0u) ? 1u : 0u; mine = (j == x) ? c : mine; }
        if (sum == G) break;
        __builtin_amdgcn_s_sleep(1);
        if ((++sp & 255u) == 0u) { if (xb_ld(&bar[XB_TMO])) break; if (sp > XB_SPIN_CAP) { atomicAdd(&bar[XB_TMO], 1u); break; } }
    }
    nloc = mine > 0u ? mine : 1u; nx = cnt > 0u ? cnt : 1u;
}
__device__ __forceinline__ void xcd_barrier(const XcdBarrier& b) {
    asm volatile("s_waitcnt vmcnt(0)" ::: "memory");
    __syncthreads();
    if (threadIdx.x == 0) {
        unsigned* bar = b.bar;
        __builtin_amdgcn_s_waitcnt(0);
        unsigned nloc = b.st[0], nx = b.st[1];
        if (nloc == 0u) { xcd_barrier_complete(bar, b.x, nloc, nx); b.st[0] = nloc; b.st[1] = nx; }
        const unsigned old = xb_add(&bar[XB_XSUB(b.x)], 1u);
        const unsigned gen = old / nloc;
        if (old + 1u == (gen + 1u) * nloc) {
            __builtin_amdgcn_fence(__ATOMIC_RELEASE, "agent");
            asm volatile("s_waitcnt vmcnt(0)" ::: "memory");
            const unsigned og = xb_add(&bar[XB_TOP], 1u);
            const unsigned tg = og / nx;
            if (og + 1u == (tg + 1u) * nx) xb_add(&bar[XB_TOPGEN], 1u);
            else XB_SPIN(xb_ld(&bar[XB_TOPGEN]) == tg, bar);
            __builtin_amdgcn_fence(__ATOMIC_ACQUIRE, "agent");
            xb_add(&bar[XB_XGEN(b.x)], 1u);
            asm volatile("s_waitcnt vmcnt(0)" ::: "memory");
        } else {
            XB_SPIN(xb_ld(&bar[XB_XGEN(b.x)]) == gen, bar);
            __builtin_amdgcn_fence(__ATOMIC_ACQUIRE, "agent");
            asm volatile("s_waitcnt vmcnt(0)" ::: "memory");
        }
    }
    __syncthreads();
}

namespace pg8 {
constexpr int BM = 256, BK = 64, HALF = 128, HTB = HALF * BK * 2, STAGE_BYTES = 8 * HTB, NXCD = 8, WGM = 8;
__host__ __device__ __forceinline__ int lds_byte(int r, int c) { const int st = (r >> 4) * 2 + (c >> 5), rr = r & 15, cc = c & 31, ob = rr * 64 + cc * 2; return st * 1024 + (ob ^ (((ob >> 9) & 1) << 5)); }
__host__ __device__ __forceinline__ void stage_rc(int b, int& R, int& C) { const int st = b / 1024, sb = b % 1024, swz = sb ^ (((sb >> 9) & 1) << 5); R = (st >> 1) * 16 + swz / 64; C = (st & 1) * 32 + (swz % 64) / 2; }
__host__ __device__ __forceinline__ int perm32(int rho) { const int n = rho >> 4, i = rho & 15; return 8 * (i >> 2) + 4 * n + (i & 3); }

struct Unit { int pm, pn, seg, aux; };

__device__ __forceinline__ int xcd_remap(int wgid, int nwg) { const int q = nwg / NXCD, r = nwg % NXCD, xcd = wgid % NXCD, off = wgid / NXCD; return (xcd < r ? xcd * (q + 1) : r * (q + 1) + (xcd - r) * q) + off; }
__device__ __forceinline__ void tile_of(int wgid, int nM, int nN, int& pm, int& pn) { const int nig = WGM * nN, gid = wgid / nig, fm = gid * WGM, gsz = (nM - fm) < WGM ? (nM - fm) : WGM; pm = fm + ((wgid % nig) % gsz); pn = (wgid % nig) / gsz; }

template <class Epi, class Sched>
__device__ __forceinline__ void gemm_phase(LAS unsigned char* lds, const int K, const int lda, const int ldb, const Sched& S, const Epi& E) {
    const int tid = threadIdx.x, wid = __builtin_amdgcn_readfirstlane(tid >> 6), lane = tid & 63, wr = wid >> 2, wc = wid & 3, fr = lane & 15, fq = lane >> 4;
    const int nt = K / BK;
    int Rr[2], Cc[2];
    unsigned voffA[2], voffB[2];
#pragma unroll
    for (int i = 0; i < 2; ++i) { int R, C; stage_rc(tid * 16 + i * 8192, R, C); Rr[i] = R; Cc[i] = C; const int Rb = Epi::PERM ? ((R & ~31) + perm32(R & 31)) : R;
        voffA[i] = (unsigned)(R * lda + C) * 2u; voffB[i] = (unsigned)(Rb * ldb + C) * 2u; }
    const size_t kstep = (size_t)(BK * 2);
    const size_t hstepA = (size_t)HALF * lda * 2, hstepB = (size_t)HALF * ldb * 2;
    const unsigned ldsw = (unsigned)wid * 1024u;
    const int aoff = lds_byte(wr * 64 + fr, fq * 8), boff = lds_byte(wc * 32 + fr, fq * 8);
#define PG8_SA(b, h) (((b) * 2 + (h)) * HTB)
#define PG8_SB(b, h) ((4 + (b) * 2 + (h)) * HTB)
#define PG8_STAGE(bufoff, gbase, voff) do { _Pragma("unroll") for (int _i = 0; _i < 2; ++_i) \
        __builtin_amdgcn_global_load_lds((const unsigned*)((const char*)(gbase) + (voff)[_i]), (LAS unsigned*)(lds + (bufoff) + ldsw + _i * 8192), 16, 0, 0); } while (0)
#define PG8_STAGE_A(bufoff, p, h, vo) do { if constexpr (Sched::GATHER) { PG8_STAGE(bufoff, p, (vo)[h]); } else { PG8_STAGE(bufoff, (p) + (h) * hstepA, voffA); } } while (0)
#define PG8_LDA(dst, b, h) do { _Pragma("unroll") for (int m = 0; m < 4; ++m) _Pragma("unroll") for (int k = 0; k < 2; ++k) dst[m][k] = *(const LAS bf16x8*)(lds + PG8_SA(b, h) + aoff + m * 2048 + k * 1024); } while (0)
#define PG8_LDB(dst, b, h) do { _Pragma("unroll") for (int n = 0; n < 2; ++n) _Pragma("unroll") for (int k = 0; k < 2; ++k) dst[n][k] = *(const LAS bf16x8*)(lds + PG8_SB(b, h) + boff + n * 2048 + k * 1024); } while (0)
#define PG8_MMA(ai, bj, At, Bt) do { __builtin_amdgcn_s_setprio(1); _Pragma("unroll") for (int m = 0; m < 4; ++m) _Pragma("unroll") for (int n = 0; n < 2; ++n) _Pragma("unroll") for (int k = 0; k < 2; ++k) \
        acc[ai][bj][m][n] = __builtin_amdgcn_mfma_f32_16x16x32_bf16(Bt[n][k], At[m][k], acc[ai][bj][m][n], 0, 0, 0); __builtin_amdgcn_s_setprio(0); } while (0)
#define PG8_WAIT_V(n) asm volatile("s_waitcnt vmcnt(" #n ")" ::: "memory")
#define PG8_WAIT_L(n) asm volatile("s_waitcnt lgkmcnt(" #n ")" ::: "memory")
#define PG8_BAR __builtin_amdgcn_s_barrier()
#define PG8_SCHED __builtin_amdgcn_sched_barrier(0)
    Unit cur, nxt; int ui = 0;
    if (!S.next(0, cur)) return;
    f32x4 acc[2][2][4][2];
#pragma unroll
    for (int a = 0; a < 2; ++a)
#pragma unroll
        for (int b = 0; b < 2; ++b)
#pragma unroll
            for (int m = 0; m < 4; ++m)
#pragma unroll
                for (int n = 0; n < 2; ++n) acc[a][b][m][n] = (f32x4){0.f, 0.f, 0.f, 0.f};
    bf16x8 At[4][2], B0[2][2], B1[2][2];
    unsigned vgc[2][2], vgn[2][2];
    const char* cA = S.abase(cur); const char* cB = S.bbase(cur);
    if constexpr (Sched::GATHER) { S.gather(cur, Rr, Cc, vgc); }
    PG8_STAGE(PG8_SB(0, 0), cB, voffB); PG8_STAGE(PG8_SB(0, 1), cB + hstepB, voffB); PG8_STAGE_A(PG8_SA(0, 0), cA, 0, vgc); PG8_STAGE_A(PG8_SA(0, 1), cA, 1, vgc);
    if (wr == 1) PG8_BAR;
    PG8_WAIT_V(2); PG8_BAR;
    PG8_STAGE(PG8_SB(1, 0), cB + kstep, voffB); PG8_STAGE_A(PG8_SA(1, 0), cA + kstep, 0, vgc); PG8_STAGE(PG8_SB(1, 1), cB + hstepB + kstep, voffB);
    PG8_WAIT_V(6); PG8_BAR;
    for (;;) {
        const bool has_next = S.next(ui + 1, nxt);
        const char* nA = has_next ? S.abase(nxt) : cA; const char* nB = has_next ? S.bbase(nxt) : cB;
        if constexpr (Sched::GATHER) { if (has_next) S.gather(nxt, Rr, Cc, vgn); else {
#pragma unroll
            for (int h = 0; h < 2; ++h)
#pragma unroll
                for (int i = 0; i < 2; ++i) vgn[h][i] = vgc[h][i]; } }
#pragma unroll 1
        for (int t = 0; t < nt; t += 2) {
            const bool last = (t == nt - 2);
            const char* a1 = cA + (size_t)(t + 1) * kstep;
            const char* a2 = last ? nA : cA + (size_t)(t + 2) * kstep; const char* b2 = last ? nB : cB + (size_t)(t + 2) * kstep;
            const char* a3 = a2 + kstep; const char* b3 = b2 + kstep;
            unsigned vg2[2][2];
            if constexpr (Sched::GATHER) {
#pragma unroll
                for (int h = 0; h < 2; ++h)
#pragma unroll
                    for (int i = 0; i < 2; ++i) vg2[h][i] = last ? vgn[h][i] : vgc[h][i]; }
            PG8_LDB(B0, 0, 0); PG8_LDB(B1, 0, 1); PG8_SCHED; PG8_LDA(At, 0, 0); PG8_STAGE_A(PG8_SA(1, 1), a1, 1, vgc);
            PG8_WAIT_V(8); PG8_WAIT_L(0); PG8_BAR; PG8_MMA(0, 0, At, B0); PG8_MMA(0, 1, At, B1); PG8_BAR; PG8_SCHED;
            PG8_LDA(At, 0, 1); PG8_STAGE(PG8_SB(0, 0), b2, voffB); PG8_STAGE(PG8_SB(0, 1), b2 + hstepB, voffB); PG8_STAGE_A(PG8_SA(0, 0), a2, 0, vg2);
            PG8_WAIT_V(8); PG8_WAIT_L(0); PG8_BAR; PG8_MMA(1, 0, At, B0); PG8_MMA(1, 1, At, B1); PG8_BAR; PG8_SCHED;
            PG8_LDB(B0, 1, 0); PG8_LDB(B1, 1, 1); PG8_SCHED; PG8_LDA(At, 1, 0); PG8_STAGE_A(PG8_SA(0, 1), a2, 1, vg2);
            PG8_WAIT_V(8); PG8_WAIT_L(0); PG8_BAR; PG8_MMA(0, 0, At, B0); PG8_MMA(0, 1, At, B1); PG8_BAR; PG8_SCHED;
            PG8_LDA(At, 1, 1); PG8_STAGE(PG8_SB(1, 0), b3, voffB); PG8_STAGE(PG8_SB(1, 1), b3 + hstepB, voffB); PG8_STAGE_A(PG8_SA(1, 0), a3, 0, vg2);
            PG8_WAIT_V(8); PG8_WAIT_L(0); PG8_BAR; PG8_MMA(1, 0, At, B0); PG8_MMA(1, 1, At, B1); PG8_BAR; PG8_SCHED;
        }
        if (wr == 0) PG8_BAR;
        E(acc, cur, wr, wc, fr, fq);
        if (!has_next) break;
#pragma unroll
        for (int a = 0; a < 2; ++a)
#pragma unroll
            for (int b = 0; b < 2; ++b)
#pragma unroll
                for (int m = 0; m < 4; ++m)
#pragma unroll
                    for (int n = 0; n < 2; ++n) acc[a][b][m][n] = (f32x4){0.f, 0.f, 0.f, 0.f};
        cur = nxt; cA = nA; cB = nB; ++ui;
        if constexpr (Sched::GATHER) {
#pragma unroll
            for (int h = 0; h < 2; ++h)
#pragma unroll
                for (int i = 0; i < 2; ++i) vgc[h][i] = vgn[h][i]; }
        if (wr == 1) PG8_BAR;
    }
    PG8_WAIT_V(0);
    PG8_BAR;
#undef PG8_SA
#undef PG8_SB
#undef PG8_STAGE
#undef PG8_STAGE_A
#undef PG8_LDA
#undef PG8_LDB
#undef PG8_MMA
#undef PG8_WAIT_V
#undef PG8_WAIT_L
#undef PG8_BAR
#undef PG8_SCHED
}
}

struct Args { const float* in[26]; float* out; unsigned char* ws; int ph_lo, ph_hi; };
enum { I_X = 0, I_P, I_WIN, I_BIN, I_CONVW, I_CONVB, I_MHG, I_WPOOL, I_PSCALE, I_WMBR, I_WPBR, I_WOUT, I_LN1G, I_LN1B, I_WRG, I_BRG, I_WRE, I_BRE, I_WGATE, I_WUP, I_WDOWN, I_LN2G, I_LN2B, I_WPG, I_BPG, I_WPP };

struct Frame {
    LAS unsigned char* lds;
    int tid, lane, wave, vcu, G;
    unsigned char* ws; unsigned char* outb;
};

__device__ __forceinline__ void transpose_tile(const float* src, int ldw, bf16_t* dst, int ldd, LAS float* scr, int lane) {
    const int kk = lane >> 4, n4 = lane & 15;
    f32x4 v[16];
#pragma unroll
    for (int i = 0; i < 16; ++i) v[i] = *(const GAS f32x4*)(src + (size_t)(4 * i + kk) * ldw + 4 * n4);
#pragma unroll
    for (int i = 0; i < 16; ++i) { const int k = 4 * i + kk;
        scr[(4 * n4 + 0) * 65 + k] = v[i].x; scr[(4 * n4 + 1) * 65 + k] = v[i].y; scr[(4 * n4 + 2) * 65 + k] = v[i].z; scr[(4 * n4 + 3) * 65 + k] = v[i].w; }
    asm volatile("s_waitcnt lgkmcnt(0)" ::: "memory");
    const int c8 = lane & 7;
#pragma unroll
    for (int j = 0; j < 8; ++j) { const int n = (lane >> 3) + 8 * j; const LAS float* s = scr + n * 65 + 8 * c8;
        u32x4 o; o.x = cvt_pk_bf16(s[0], s[1]); o.y = cvt_pk_bf16(s[2], s[3]); o.z = cvt_pk_bf16(s[4], s[5]); o.w = cvt_pk_bf16(s[6], s[7]);
        *(GAS u32x4*)(dst + (size_t)n * ldd + 8 * c8) = o; }
    asm volatile("s_waitcnt lgkmcnt(0)" ::: "memory");
}

__device__ __forceinline__ void p0_prologue(Frame& F, const Args& args) {
    unsigned char* ws = F.ws;
    const int gw = F.vcu * NWAVES + F.wave, NGW = F.G * NWAVES;
    LAS float* scr = (LAS float*)(F.lds + F.wave * 16640);
    constexpr int T_WIN_A = 32 * 48, T_WIN_B = 32 * 80, T_MBR = 16 * 32, T_OUT = 32 * 32, T_PG = 32 * 32, T_PP = 4 * 32;
    constexpr int T_G1 = 32 * 12, T_DN1 = 12 * 32;
    constexpr int T_MOE = N_EXPERTS * (2 * T_G1 + T_DN1);
    constexpr int NT = T_WIN_A + T_WIN_B + T_MBR + T_OUT + T_PG + T_PP + T_MOE;
    for (int it = gw; it < NT; it += NGW) {
        int r = it;
        if (r < T_WIN_A) { const int kb = r / 48, nb = r % 48; transpose_tile(args.in[I_WIN] + (size_t)(64 * kb) * IN_DIM + 64 * nb, IN_DIM, (bf16_t*)(ws + W_IN) + (size_t)(64 * nb) * 2048 + 64 * kb, 2048, scr, F.lane); continue; } r -= T_WIN_A;
        if (r < T_WIN_B) { const int kb = r / 80, nb = r % 80; transpose_tile(args.in[I_WIN] + (size_t)(64 * kb) * IN_DIM + 3080 + 64 * nb, IN_DIM, (bf16_t*)(ws + W_IN) + (size_t)(3072 + 64 * nb) * 2048 + 64 * kb, 2048, scr, F.lane); continue; } r -= T_WIN_B;
        if (r < T_MBR) { const int kb = r / 32, nb = r % 32; transpose_tile(args.in[I_WMBR] + (size_t)(64 * kb) * 2048 + 64 * nb, 2048, (bf16_t*)(ws + W_MBR) + (size_t)(64 * nb) * 1024 + 64 * kb, 1024, scr, F.lane); continue; } r -= T_MBR;
        if (r < T_OUT) { const int kb = r / 32, nb = r % 32; transpose_tile(args.in[I_WOUT] + (size_t)(64 * kb) * 2048 + 64 * nb, 2048, (bf16_t*)(ws + W_OUT) + (size_t)(64 * nb) * 2048 + 64 * kb, 2048, scr, F.lane); continue; } r -= T_OUT;
        if (r < T_PG) { const int kb = r / 32, nb = r % 32; transpose_tile(args.in[I_WPG] + (size_t)(64 * kb) * 2048 + 64 * nb, 2048, (bf16_t*)(ws + W_PG) + (size_t)(64 * nb) * 2048 + 64 * kb, 2048, scr, F.lane); continue; } r -= T_PG;
        if (r < T_PP) { const int kb = r / 32, nb = r % 32; transpose_tile(args.in[I_WPP] + (size_t)(64 * kb) * 2048 + 64 * nb, 2048, (bf16_t*)(ws + W_PP) + (size_t)(64 * nb) * 256 + 64 * kb, 256, scr, F.lane); continue; } r -= T_PP;
        { const int e = r / (2 * T_G1 + T_DN1); int q = r % (2 * T_G1 + T_DN1);
          if (q < 2 * T_G1) { const int up = q / T_G1; q %= T_G1; const int kb = q / 12, nb = q % 12; const int n0 = 64 * nb;
              const float* src = args.in[up ? I_WUP : I_WGATE] + (size_t)e * 2048 * 768 + (size_t)(64 * kb) * 768 + n0;
              bf16_t* dst = (bf16_t*)(ws + W_GU) + ((size_t)e * 1536 + (n0 >> 7) * 256 + (n0 & 127) + (up ? 128 : 0)) * 2048 + 64 * kb;
              transpose_tile(src, 768, dst, 2048, scr, F.lane); }
          else { q -= 2 * T_G1; const int kb = q / 32, nb = q % 32;
              transpose_tile(args.in[I_WDOWN] + (size_t)e * 768 * 2048 + (size_t)(64 * kb) * 2048 + 64 * nb, 2048, (bf16_t*)(ws + W_DN) + ((size_t)e * 2048 + 64 * nb) * 768 + 64 * kb, 768, scr, F.lane); } }
    }
    {
        const float* wpool = args.in[I_WPOOL]; const float* ps = args.in[I_PSCALE]; const float* wpbr = args.in[I_WPBR];
        bf16_t* weff = (bf16_t*)(ws + W_EFF);
        for (int it = gw; it < 128 * 32; it += NGW) {
            const int kg = it >> 5, n = ((it & 31) << 6) + F.lane, g = kg >> 5, c0 = (kg & 31) * 8;
            float a[8];
#pragma unroll
            for (int i = 0; i < 8; ++i) a[i] = 0.f;
            const float* wp = wpool + ((size_t)g * 256 + c0) * 256; const float* psg = ps + g * 256; const float* wb = wpbr + (size_t)(g * 256) * 2048 + n;
#pragma unroll 4
            for (int d = 0; d < 256; ++d) { const float b = psg[d] * wb[(size_t)d * 2048];
#pragma unroll
                for (int i = 0; i < 8; ++i) a[i] += wp[i * 256 + d] * b; }
            u32x4 o; o.x = cvt_pk_bf16(a[0], a[1]); o.y = cvt_pk_bf16(a[2], a[3]); o.z = cvt_pk_bf16(a[4], a[5]); o.w = cvt_pk_bf16(a[6], a[7]);
            *(GAS u32x4*)(weff + (size_t)n * 1024 + g * 256 + c0) = o;
        }
    }
    {
        bf16_t* wr = (bf16_t*)(ws + W_RT);
        const int gt = F.vcu * NTHREADS + F.tid, NGT = F.G * NTHREADS;
        for (int idx = gt; idx < 48 * 2048; idx += NGT) { const int n = idx >> 11, k = idx & 2047;
            float w = 0.f; if (n < 4) w = args.in[I_WRG][k * 4 + n]; else if (n < 36) w = args.in[I_WRE][k * 32 + (n - 4)];
            const unsigned hi = cvt_pk_bf16(w, 0.f) & 0xffffu; const float lo = w - __uint_as_float(hi << 16);
            wr[idx] = (bf16_t)hi; wr[48 * 2048 + idx] = (bf16_t)(cvt_pk_bf16(lo, 0.f) & 0xffffu); }
        const f32x4* p4 = (const f32x4*)args.in[I_P]; u32x2* pb = (u32x2*)(ws + WS_PB);
        for (int idx = gt; idx < T_TOK * PLE_DIM / 4; idx += NGT) { const f32x4 v = p4[idx]; u32x2 o; o.x = cvt_pk_bf16(v.x, v.y); o.y = cvt_pk_bf16(v.z, v.w); pb[idx] = o; }
    }
    {
        __syncthreads();
        LAS float* wg = (LAS float*)F.lds;
        for (int idx = F.tid; idx < 8 * 2048; idx += NTHREADS) { const int e = idx >> 3, c = idx & 7; wg[c * 2048 + e] = args.in[I_WIN][(size_t)e * IN_DIM + 3072 + c]; }
        __syncthreads();
        const float* x = args.in[I_X]; bf16_t* xb = (bf16_t*)(F.outb + OUT_XB); float* gates = (float*)(ws + WS_SMALL + SM_GATES);
        for (int row = gw; row < T_TOK; row += NGW) {
            float g[8];
#pragma unroll
            for (int c = 0; c < 8; ++c) g[c] = 0.f;
#pragma unroll
            for (int itx = 0; itx < 4; ++itx) {
                const int e0 = itx * 512 + F.lane * 8;
                const f32x4 v0 = *(const GAS f32x4*)(x + (size_t)row * 2048 + e0), v1 = *(const GAS f32x4*)(x + (size_t)row * 2048 + e0 + 4);
                u32x4 o; o.x = cvt_pk_bf16(v0.x, v0.y); o.y = cvt_pk_bf16(v0.z, v0.w); o.z = cvt_pk_bf16(v1.x, v1.y); o.w = cvt_pk_bf16(v1.z, v1.w);
                *(GAS u32x4*)(xb + (size_t)row * 2048 + e0) = o;
#pragma unroll
                for (int c = 0; c < 8; ++c) { const f32x4 w0 = *(const LAS f32x4*)(wg + c * 2048 + e0), w1 = *(const LAS f32x4*)(wg + c * 2048 + e0 + 4);
                    g[c] += (v0.x * w0.x + v0.y * w0.y) + (v0.z * w0.z + v0.w * w0.w) + (v1.x * w1.x + v1.y * w1.y) + (v1.z * w1.z + v1.w * w1.w); }
            }
#pragma unroll
            for (int c = 0; c < 8; ++c) g[c] = wave_sum(g[c]);
            if (F.lane < 8) { float s = g[0];
#pragma unroll
                for (int c = 1; c < 8; ++c) s = (F.lane == c) ? g[c] : s;
                gates[(size_t)row * 8 + F.lane] = s + args.in[I_BIN][3072 + F.lane]; }
        }
        __syncthreads();
    }
}

__device__ __forceinline__ void gate_scan(Frame& F, int bh) {
    unsigned char* ws = F.ws;
    const int b = bh >> 2, h = bh & 3, tid = F.tid, lane = F.lane;
    const float* gates = (const float*)(ws + WS_SMALL + SM_GATES);
    LAS float* sA = (LAS float*)F.lds; LAS float* sB = sA + 32; LAS float* sMC = sA + 64; LAS float* sML = sA + 96;
    float ig[8], bb[8], aa[8];
    float run = 0.f;
#pragma unroll
    for (int i = 0; i < 8; ++i) { const size_t t = (size_t)b * SEQ + tid * 8 + i; ig[i] = gates[t * 8 + h]; const float fg = gates[t * 8 + 4 + h];
        const float lf = fminf(fg, 0.f) - log1pf(expf(-fabsf(fg))); run += lf; bb[i] = run; }
    const float tot = run; float v = tot;
#pragma unroll
    for (int off = 1; off < 16; off <<= 1) { const float n = __shfl_up(v, off, 16); if ((lane & 15) >= off) v += n; }
    const float excl = v - tot;
    float amax = -INFINITY;
#pragma unroll
    for (int i = 0; i < 8; ++i) { bb[i] += excl; aa[i] = ig[i] - bb[i]; amax = fmaxf(amax, aa[i]); }
    float gmax = amax;
#pragma unroll
    for (int off = 1; off < 16; off <<= 1) gmax = fmaxf(gmax, __shfl_xor(gmax, off, 16));
    const float blast = __shfl(bb[7], 15, 16);
    const int chunk = tid >> 4;
    if ((tid & 15) == 0) { sA[chunk] = gmax; sB[chunk] = blast; }
    __syncthreads();
    if (tid == 0) { float m = 0.f; for (int c = 0; c < NCHUNK; ++c) { sMC[c] = m; const float Ml = fmaxf(m, sA[c]); sML[c] = Ml; m = sB[c] + Ml; } }
    __syncthreads();
    const float mc = sMC[chunk];
    float pm = amax;
#pragma unroll
    for (int off = 1; off < 16; off <<= 1) { const float n = __shfl_up(pm, off, 16); if ((lane & 15) >= off) pm = fmaxf(pm, n); }
    float ex = __shfl_up(pm, 1, 16); if ((lane & 15) == 0) ex = -INFINITY;
    float cm = fmaxf(mc, ex);
    float* AT = (float*)(ws + WS_SMALL + SM_AT) + (size_t)bh * SEQ + tid * 8; float* MRp = (float*)(ws + WS_SMALL + SM_MR) + (size_t)bh * SEQ + tid * 8; float* EMp = (float*)(ws + WS_SMALL + SM_EM) + (size_t)bh * SEQ + tid * 8;
#pragma unroll
    for (int i = 0; i < 8; ++i) { cm = fmaxf(cm, aa[i]); AT[i] = aa[i]; MRp[i] = cm; EMp[i] = expf(-(bb[i] + cm)); }
    if (tid < NCHUNK) { ((float*)(ws + WS_SMALL + SM_MC))[bh * NCHUNK + tid] = sMC[tid]; ((float*)(ws + WS_SMALL + SM_ML))[bh * NCHUNK + tid] = sML[tid];
        ((float*)(ws + WS_SMALL + SM_DEC))[bh * NCHUNK + tid] = expf(sMC[tid] - sML[tid]); }
    __syncthreads();
}

__device__ __forceinline__ bf16x8 tr_frag(const LAS unsigned char* base, int stride, int row0, int col0, int lane) {
    const int g = lane >> 4, q = (lane & 15) >> 2, p = lane & 3;
    const LAS unsigned char* a = base + (row0 + 8 * g + q) * stride + (col0 + 4 * p) * 2;
    const s16x4 lo = __builtin_amdgcn_ds_read_tr16_b64_v4i16((LAS s16x4*)a);
    const s16x4 hi = __builtin_amdgcn_ds_read_tr16_b64_v4i16((LAS s16x4*)(a + 4 * stride));
    bf16x8 r; r[0] = lo[0]; r[1] = lo[1]; r[2] = lo[2]; r[3] = lo[3]; r[4] = hi[0]; r[5] = hi[1]; r[6] = hi[2]; r[7] = hi[3]; return r;
}
__device__ __forceinline__ bf16x8 row_frag(const LAS unsigned char* base, int stride, int row0, int col0, int lane) {
    return *(const LAS bf16x8*)(base + (row0 + (lane & 15)) * stride + (col0 + 8 * (lane >> 4)) * 2);
}
constexpr int QK_STRIDE = 272;
constexpr int V_STRIDE = 560;
constexpr int MS_QS = 0, MS_KS = 34816, MS_XS = 69632, MS_SMALL = MS_XS + 73984;
static_assert(MS_SMALL + 1536 <= LDS_USABLE, "mLSTM LDS map");

__device__ __forceinline__ void stage_conv_tile(Frame& F, const Args& args, LAS unsigned char* dst, int zcol0, size_t t0, bool first, float scale) {
    const bf16_t* Z = (const bf16_t*)(F.ws + WS_Z);
    const int ch = F.tid & 15, r0 = F.tid >> 4;
    const float* cw = args.in[I_CONVW] + zcol0 + ch * 8; const float* cb = args.in[I_CONVB] + zcol0 + ch * 8;
    float w[4][8], bias[8];
#pragma unroll
    for (int tap = 0; tap < 4; ++tap) { const f32x4 a = *(const f32x4*)(cw + tap * 1024), b = *(const f32x4*)(cw + tap * 1024 + 4);
        w[tap][0] = a.x; w[tap][1] = a.y; w[tap][2] = a.z; w[tap][3] = a.w; w[tap][4] = b.x; w[tap][5] = b.y; w[tap][6] = b.z; w[tap][7] = b.w; }
    { const f32x4 a = *(const f32x4*)cb, b = *(const f32x4*)(cb + 4); bias[0] = a.x; bias[1] = a.y; bias[2] = a.z; bias[3] = a.w; bias[4] = b.x; bias[5] = b.y; bias[6] = b.z; bias[7] = b.w; }
#pragma unroll
    for (int i = 0; i < 4; ++i) {
        const int l = r0 + 32 * i;
        float o[8];
#pragma unroll
        for (int j = 0; j < 8; ++j) o[j] = bias[j];
#pragma unroll
        for (int tap = 0; tap < 4; ++tap) {
            const int lr = l - 3 + tap;
            u32x4 u = (u32x4){0u, 0u, 0u, 0u};
            if (!first || lr >= 0) u = *(const GAS u32x4*)(Z + (size_t)((long)t0 + lr) * ZW + zcol0 + ch * 8);
            o[0] += w[tap][0] * bf_lo(u.x); o[1] += w[tap][1] * bf_hi(u.x); o[2] += w[tap][2] * bf_lo(u.y); o[3] += w[tap][3] * bf_hi(u.y);
            o[4] += w[tap][4] * bf_lo(u.z); o[5] += w[tap][5] * bf_hi(u.z); o[6] += w[tap][6] * bf_lo(u.w); o[7] += w[tap][7] * bf_hi(u.w);
        }
#pragma unroll
        for (int j = 0; j < 8; ++j) o[j] = o[j] * sigmoidf_(o[j]) * scale;
        u32x4 pk; pk.x = cvt_pk_bf16(o[0], o[1]); pk.y = cvt_pk_bf16(o[2], o[3]); pk.z = cvt_pk_bf16(o[4], o[5]); pk.w = cvt_pk_bf16(o[6], o[7]);
        *(LAS u32x4*)(dst + l * QK_STRIDE + ch * 16) = pk;
    }
}
__device__ __forceinline__ void stage_v_tile(Frame& F, LAS unsigned char* dst, int zcol0, size_t t0, const LAS float* wl) {
    const bf16_t* Z = (const bf16_t*)(F.ws + WS_Z);
    const int ch = F.tid & 31, r0 = F.tid >> 5;
#pragma unroll
    for (int i = 0; i < 8; ++i) {
        const int l = r0 + 16 * i;
        const u32x4 u = *(const GAS u32x4*)(Z + (size_t)(t0 + l) * ZW + zcol0 + ch * 8);
        u32x4 pk = u;
        if (wl) { const float w = wl[l];
            pk.x = cvt_pk_bf16(w * bf_lo(u.x), w * bf_hi(u.x)); pk.y = cvt_pk_bf16(w * bf_lo(u.y), w * bf_hi(u.y)); pk.z = cvt_pk_bf16(w * bf_lo(u.z), w * bf_hi(u.z)); pk.w = cvt_pk_bf16(w * bf_lo(u.w), w * bf_hi(u.w)); }
        *(LAS u32x4*)(dst + l * V_STRIDE + ch * 16) = pk;
    }
    if (F.tid < 128) { const float w = wl ? wl[F.tid] : 1.0f; u32x4 a = (u32x4){cvt_pk_bf16(w, 0.f), 0u, 0u, 0u}; const u32x4 z = (u32x4){0u, 0u, 0u, 0u};
        *(LAS u32x4*)(dst + F.tid * V_STRIDE + 512) = a; *(LAS u32x4*)(dst + F.tid * V_STRIDE + 528) = z; }
}

__device__ __forceinline__ void mlstm_m1_unit(Frame& F, const Args& args, int bh, int c) {
    const int b = bh >> 2, h = bh & 3, lane = F.lane, w = F.wave;
    const size_t t0 = (size_t)b * SEQ + c * CHUNK;
    LAS unsigned char* KS = F.lds + MS_KS; LAS unsigned char* XS = F.lds + MS_XS; LAS float* wl = (LAS float*)(F.lds + MS_SMALL);
    if (F.tid < 128) { const float a = ((const float*)(F.ws + WS_SMALL + SM_AT))[(size_t)bh * SEQ + c * CHUNK + F.tid]; const float Ml = ((const float*)(F.ws + WS_SMALL + SM_ML))[bh * NCHUNK + c]; wl[F.tid] = expf(a - Ml); }
    stage_conv_tile(F, args, KS, ZC_QK + M_QK + h * M_QK_DIM, t0, c == 0, 0.08838834764831845f);
    __syncthreads();
    stage_v_tile(F, XS, ZC_V + h * M_V_DIM, t0, wl);
    __syncthreads();
    f32x4 acc[17];
#pragma unroll
    for (int i = 0; i < 17; ++i) acc[i] = (f32x4){0.f, 0.f, 0.f, 0.f};
#pragma unroll
    for (int ks = 0; ks < 4; ++ks) {
        const bf16x8 kf = tr_frag(KS, QK_STRIDE, 32 * ks, 16 * w, lane);
#pragma unroll
        for (int cv = 0; cv < 17; ++cv) { const bf16x8 vf = tr_frag(XS, V_STRIDE, 32 * ks, 16 * cv, lane); acc[cv] = __builtin_amdgcn_mfma_f32_16x16x32_bf16(kf, vf, acc[cv], 0, 0, 0); }
    }
    float* dkv = (float*)(F.ws + S2_DKV) + (size_t)(bh * NCHUNK + c) * 272 * 128;
#pragma unroll
    for (int cv = 0; cv < 17; ++cv) { const int v = 16 * cv + (lane & 15); if (v <= 256) *(GAS f32x4*)(dkv + (size_t)v * 128 + 16 * w + 4 * (lane >> 4)) = acc[cv]; }
    __syncthreads();
}

__device__ __forceinline__ void mlstm_m2(Frame& F) {
    const int gt = F.vcu * NTHREADS + F.tid, NGT = F.G * NTHREADS;
    constexpr int Q4 = 257 * 128 / 4;
    const float* dec = (const float*)(F.ws + WS_SMALL + SM_DEC);
    for (int it = gt; it < NBH * Q4; it += NGT) {
        const int bh = it / Q4, q = it % Q4;
        const f32x4* src = (const f32x4*)(F.ws + S2_DKV) + (size_t)bh * NCHUNK * (272 * 128 / 4) + q;
        u32x2* dst = (u32x2*)(F.ws + S2_CST) + (size_t)bh * NCHUNK * (272 * 128 / 4) + q;
        f32x4 C = (f32x4){0.f, 0.f, 0.f, 0.f};
#pragma unroll 8
        for (int c = 0; c < NCHUNK; ++c) {
            const f32x4 d = src[(size_t)c * (272 * 128 / 4)]; const float dc = dec[bh * NCHUNK + c];
            u32x2 o; o.x = cvt_pk_bf16(C.x, C.y); o.y = cvt_pk_bf16(C.z, C.w); dst[(size_t)c * (272 * 128 / 4)] = o;
            C = C * dc + d;
        }
    }
}

__device__ __forceinline__ void mlstm_m3_unit(Frame& F, const Args& args, int bh, int c) {
    const int b = bh >> 2, h = bh & 3, lane = F.lane, w = F.wave, tid = F.tid;
    const size_t t0 = (size_t)b * SEQ + c * CHUNK;
    LAS unsigned char* QS = F.lds + MS_QS; LAS unsigned char* KS = F.lds + MS_KS; LAS unsigned char* XS = F.lds + MS_XS;
    LAS float* sa = (LAS float*)(F.lds + MS_SMALL); LAS float* smr = sa + 128; LAS float* sem = sa + 256;
    if (tid < 128) { const size_t o = (size_t)bh * SEQ + c * CHUNK + tid;
        sa[tid] = ((const float*)(F.ws + WS_SMALL + SM_AT))[o]; smr[tid] = ((const float*)(F.ws + WS_SMALL + SM_MR))[o]; sem[tid] = ((const float*)(F.ws + WS_SMALL + SM_EM))[o]; }
    const float mc = ((const float*)(F.ws + WS_SMALL + SM_MC))[bh * NCHUNK + c];
    stage_conv_tile(F, args, QS, ZC_QK + h * M_QK_DIM, t0, c == 0, 1.0f);
    stage_conv_tile(F, args, KS, ZC_QK + M_QK + h * M_QK_DIM, t0, c == 0, 0.08838834764831845f);
    { const u32x4* cst = (const u32x4*)(F.ws + S2_CST) + (size_t)(bh * NCHUNK + c) * (272 * 128 / 8);
      for (int it = tid; it < 272 * 16; it += NTHREADS) { const int r = it >> 4, ch = it & 15; u32x4 v = (u32x4){0u, 0u, 0u, 0u}; if (r <= 256) v = cst[it]; *(LAS u32x4*)(XS + r * QK_STRIDE + ch * 16) = v; } }
    __syncthreads();
    const int j = 16 * w + (lane & 15);
    const float mrj = smr[j], emj = sem[j], spj = expf(mc - mrj);
    bf16x8 qf[4];
#pragma unroll
    for (int ks = 0; ks < 4; ++ks) qf[ks] = row_frag(QS, QK_STRIDE, 16 * w, 32 * ks, lane);
    f32x4 st[8];
#pragma unroll
    for (int lt = 0; lt < 8; ++lt) { st[lt] = (f32x4){0.f, 0.f, 0.f, 0.f};
        if (lt <= w) {
#pragma unroll
            for (int ks = 0; ks < 4; ++ks) { const bf16x8 kf = row_frag(KS, QK_STRIDE, 16 * lt, 32 * ks, lane); st[lt] = __builtin_amdgcn_mfma_f32_16x16x32_bf16(kf, qf[ks], st[lt], 0, 0, 0); } } }
    f32x4 acc[17];
#pragma unroll
    for (int cv = 0; cv < 17; ++cv) { acc[cv] = (f32x4){0.f, 0.f, 0.f, 0.f};
#pragma unroll
        for (int ks = 0; ks < 4; ++ks) { const bf16x8 cf = row_frag(XS, QK_STRIDE, 16 * cv, 32 * ks, lane); acc[cv] = __builtin_amdgcn_mfma_f32_16x16x32_bf16(cf, qf[ks], acc[cv], 0, 0, 0); }
        acc[cv] = acc[cv] * spj; }
    __syncthreads();
#pragma unroll
    for (int lt = 0; lt < 8; ++lt) {
        const int l0 = 16 * lt + 4 * (lane >> 4);
        u32x2 pk = (u32x2){0u, 0u};
        if (lt <= w) { float e[4];
#pragma unroll
            for (int r = 0; r < 4; ++r) { const float f = expf(sa[l0 + r] - mrj); e[r] = (lt < w || (l0 + r) <= j) ? st[lt][r] * f : 0.f; }
            pk.x = cvt_pk_bf16(e[0], e[1]); pk.y = cvt_pk_bf16(e[2], e[3]); }
        *(LAS u32x2*)(KS + j * QK_STRIDE + l0 * 2) = pk;
    }
    stage_v_tile(F, XS, ZC_V + h * M_V_DIM, t0, nullptr);
    __syncthreads();
#pragma unroll
    for (int ks = 0; ks < 4; ++ks) {
        if (ks <= (w >> 1)) { const bf16x8 sf = row_frag(KS, QK_STRIDE, 16 * w, 32 * ks, lane);
#pragma unroll
            for (int cv = 0; cv < 17; ++cv) { const bf16x8 vf = tr_frag(XS, V_STRIDE, 32 * ks, 16 * cv, lane); acc[cv] = __builtin_amdgcn_mfma_f32_16x16x32_bf16(vf, sf, acc[cv], 0, 0, 0); } } }
    const float den = __shfl(acc[16].x, lane & 15);
    const float inv = 1.0f / fmaxf(fabsf(den), emj);
    float s = 0.f;
#pragma unroll
    for (int cv = 0; cv < 16; ++cv) { acc[cv] = acc[cv] * inv; s += (acc[cv].x + acc[cv].y) + (acc[cv].z + acc[cv].w); }
    s += __shfl_xor(s, 16); s += __shfl_xor(s, 32);
    const float mu = s * (1.0f / 256.0f);
    float q = 0.f;
#pragma unroll
    for (int cv = 0; cv < 16; ++cv) { const f32x4 d = acc[cv] - mu; q += (d.x * d.x + d.y * d.y) + (d.z * d.z + d.w * d.w); }
    q += __shfl_xor(q, 16); q += __shfl_xor(q, 32);
    const float rstd = 1.0f / sqrtf(q * (1.0f / 256.0f) + LN_EPS);
    const bf16_t* Z = (const bf16_t*)(F.ws + WS_Z); bf16_t* HG = (bf16_t*)(F.outb + OUT_HG);
    const size_t t = t0 + j;
#pragma unroll
    for (int cv = 0; cv < 16; ++cv) { const int v = h * M_V_DIM + 16 * cv + 4 * (lane >> 4);
        const f32x4 g = *(const f32x4*)(args.in[I_MHG] + v); const u32x2 so = *(const GAS u32x2*)(Z + t * ZW + ZC_O + v);
        const f32x4 d = (acc[cv] - mu) * rstd;
        u32x2 o; o.x = cvt_pk_bf16(d.x * g.x * bf_lo(so.x), d.y * g.y * bf_hi(so.x)); o.y = cvt_pk_bf16(d.z * g.z * bf_lo(so.y), d.w * g.w * bf_hi(so.y));
        *(GAS u32x2*)(HG + t * M_V + v) = o; }
    __syncthreads();
}

__device__ __forceinline__ void pool_phase(Frame& F) {
    const int gt = F.vcu * NTHREADS + F.tid, NGT = F.G * NTHREADS;
    const bf16_t* Z = (const bf16_t*)(F.ws + WS_Z); bf16_t* PU = (bf16_t*)(F.outb + OUT_PU);
    for (int it = gt; it < (T_TOK / 16) * 128; it += NGT) {
        const int ch = it & 127, run = it >> 7, col = ch * 8, win = 2 << (col >> 8);
        const size_t t0 = (size_t)run * 16; const int tb0 = (int)(t0 & (SEQ - 1));
        float sum[8];
#pragma unroll
        for (int jj = 0; jj < 8; ++jj) sum[jj] = 0.f;
        for (int k = 1; k < win; ++k) if (tb0 - k >= 0) { const u32x4 u = *(const GAS u32x4*)(Z + (t0 - k) * ZW + ZC_U + col);
            sum[0] += bf_lo(u.x); sum[1] += bf_hi(u.x); sum[2] += bf_lo(u.y); sum[3] += bf_hi(u.y); sum[4] += bf_lo(u.z); sum[5] += bf_hi(u.z); sum[6] += bf_lo(u.w); sum[7] += bf_hi(u.w); }
        for (int r = 0; r < 16; ++r) {
            const size_t t = t0 + r; const int tb = tb0 + r;
            const u32x4 u = *(const GAS u32x4*)(Z + t * ZW + ZC_U + col);
            float cur[8] = {bf_lo(u.x), bf_hi(u.x), bf_lo(u.y), bf_hi(u.y), bf_lo(u.z), bf_hi(u.z), bf_lo(u.w), bf_hi(u.w)};
            const float rc = 1.0f / (float)((tb + 1) < win ? (tb + 1) : win);
            float o[8];
#pragma unroll
            for (int jj = 0; jj < 8; ++jj) { sum[jj] += cur[jj]; o[jj] = sum[jj] * rc - cur[jj]; }
            u32x4 pk; pk.x = cvt_pk_bf16(o[0], o[1]); pk.y = cvt_pk_bf16(o[2], o[3]); pk.z = cvt_pk_bf16(o[4], o[5]); pk.w = cvt_pk_bf16(o[6], o[7]);
            *(GAS u32x4*)(PU + t * POOL_W + col) = pk;
            if (tb - win + 1 >= 0) { const u32x4 v = *(const GAS u32x4*)(Z + (t - win + 1) * ZW + ZC_U + col);
                sum[0] -= bf_lo(v.x); sum[1] -= bf_hi(v.x); sum[2] -= bf_lo(v.y); sum[3] -= bf_hi(v.y); sum[4] -= bf_lo(v.z); sum[5] -= bf_hi(v.z); sum[6] -= bf_lo(v.w); sum[7] -= bf_hi(v.w); }
        }
    }
}

constexpr int RT_XSTRIDE = 4112;
constexpr int RT_XL = 16 * RT_XSTRIDE, RT_LG = 32768;
static_assert(2 * RT_XL <= LDS_USABLE, "router LDS map");
__device__ __forceinline__ void ln1_router_phase(Frame& F, const Args& args) {
    const int lane = F.lane, w = F.wave, tid = F.tid;
    float* X1 = (float*)(F.ws + Z_X1); bf16_t* X1B = (bf16_t*)(F.ws + S2_X1B);
    const bf16_t* WRh = (const bf16_t*)(F.ws + W_RT); const bf16_t* WRl = WRh + 48 * 2048;
    unsigned* cnt = (unsigned*)(F.ws + WS_CTL) + CW_CNT; int* TL = (int*)(F.ws + WS_SMALL + SM_TL); float* GWp = (float*)(F.ws + WS_SMALL + SM_GW);
    LAS unsigned char* XH = F.lds; LAS unsigned char* XL = F.lds + RT_XL; LAS f32x4* red = (LAS f32x4*)F.lds; LAS float* lg = (LAS float*)(F.lds + RT_LG);
    float g[32], bb[32];
#pragma unroll
    for (int i = 0; i < 4; ++i) { const int e0 = i * 512 + lane * 8;
        const f32x4 a0 = *(const f32x4*)(args.in[I_LN1G] + e0), a1 = *(const f32x4*)(args.in[I_LN1G] + e0 + 4), b0 = *(const f32x4*)(args.in[I_LN1B] + e0), b1 = *(const f32x4*)(args.in[I_LN1B] + e0 + 4);
        g[8 * i + 0] = a0.x; g[8 * i + 1] = a0.y; g[8 * i + 2] = a0.z; g[8 * i + 3] = a0.w; g[8 * i + 4] = a1.x; g[8 * i + 5] = a1.y; g[8 * i + 6] = a1.z; g[8 * i + 7] = a1.w;
        bb[8 * i + 0] = b0.x; bb[8 * i + 1] = b0.y; bb[8 * i + 2] = b0.z; bb[8 * i + 3] = b0.w; bb[8 * i + 4] = b1.x; bb[8 * i + 5] = b1.y; bb[8 * i + 6] = b1.z; bb[8 * i + 7] = b1.w; }
    for (int grp = F.vcu; grp < T_TOK / 16; grp += F.G) {
#pragma unroll 1
        for (int rr = 0; rr < 2; ++rr) {
            const int lr = 2 * w + rr; const size_t row = (size_t)grp * 16 + lr;
            float v[32]; float s = 0.f;
#pragma unroll
            for (int i = 0; i < 4; ++i) { const int e0 = i * 512 + lane * 8; const f32x4 a = *(const GAS f32x4*)(X1 + row * 2048 + e0), b = *(const GAS f32x4*)(X1 + row * 2048 + e0 + 4);
                v[8 * i + 0] = a.x; v[8 * i + 1] = a.y; v[8 * i + 2] = a.z; v[8 * i + 3] = a.w; v[8 * i + 4] = b.x; v[8 * i + 5] = b.y; v[8 * i + 6] = b.z; v[8 * i + 7] = b.w; }
#pragma unroll
            for (int i = 0; i < 32; ++i) s += v[i];
            const float mean = wave_sum(s) * (1.0f / 2048.0f); float q = 0.f;
#pragma unroll
            for (int i = 0; i < 32; ++i) { v[i] -= mean; q += v[i] * v[i]; }
            const float rstd = 1.0f / sqrtf(wave_sum(q) * (1.0f / 2048.0f) + LN_EPS);
#pragma unroll
            for (int i = 0; i < 4; ++i) { const int e0 = i * 512 + lane * 8; float y[8];
#pragma unroll
                for (int k = 0; k < 8; ++k) y[k] = v[8 * i + k] * rstd * g[8 * i + k] + bb[8 * i + k];
                *(GAS f32x4*)(X1 + row * 2048 + e0) = (f32x4){y[0], y[1], y[2], y[3]}; *(GAS f32x4*)(X1 + row * 2048 + e0 + 4) = (f32x4){y[4], y[5], y[6], y[7]};
                u32x4 hi; hi.x = cvt_pk_bf16(y[0], y[1]); hi.y = cvt_pk_bf16(y[2], y[3]); hi.z = cvt_pk_bf16(y[4], y[5]); hi.w = cvt_pk_bf16(y[6], y[7]);
                *(GAS u32x4*)(X1B + row * 2048 + e0) = hi;
                u32x4 lo; lo.x = cvt_pk_bf16(y[0] - bf_lo(hi.x), y[1] - bf_hi(hi.x)); lo.y = cvt_pk_bf16(y[2] - bf_lo(hi.y), y[3] - bf_hi(hi.y)); lo.z = cvt_pk_bf16(y[4] - bf_lo(hi.z), y[5] - bf_hi(hi.z)); lo.w = cvt_pk_bf16(y[6] - bf_lo(hi.w), y[7] - bf_hi(hi.w));
                *(LAS u32x4*)(XH + lr * RT_XSTRIDE + e0 * 2) = hi; *(LAS u32x4*)(XL + lr * RT_XSTRIDE + e0 * 2) = lo; }
        }
        __syncthreads();
        f32x4 acc[3];
#pragma unroll
        for (int t = 0; t < 3; ++t) acc[t] = (f32x4){0.f, 0.f, 0.f, 0.f};
#pragma unroll 2
        for (int s8 = 0; s8 < 8; ++s8) {
            const int kk = 256 * w + 32 * s8 + 8 * (lane >> 4);
            const bf16x8 ah = *(const LAS bf16x8*)(XH + (lane & 15) * RT_XSTRIDE + kk * 2), al = *(const LAS bf16x8*)(XL + (lane & 15) * RT_XSTRIDE + kk * 2);
#pragma unroll
            for (int t = 0; t < 3; ++t) { const size_t o = (size_t)(16 * t + (lane & 15)) * 2048 + kk;
                const bf16x8 bh = *(const GAS bf16x8*)(WRh + o), bl = *(const GAS bf16x8*)(WRl + o);
                acc[t] = __builtin_amdgcn_mfma_f32_16x16x32_bf16(ah, bh, acc[t], 0, 0, 0); acc[t] = __builtin_amdgcn_mfma_f32_16x16x32_bf16(al, bh, acc[t], 0, 0, 0); acc[t] = __builtin_amdgcn_mfma_f32_16x16x32_bf16(ah, bl, acc[t], 0, 0, 0); }
        }
        __syncthreads();
#pragma unroll
        for (int t = 0; t < 3; ++t) red[(w * 3 + t) * 64 + lane] = acc[t];
        __syncthreads();
        for (int idx = tid; idx < 16 * 36; idx += NTHREADS) { const int row = idx / 36, n = idx % 36, t = n >> 4, sl = (row >> 2) * 16 + (n & 15), rg = row & 3;
            float s = 0.f;
#pragma unroll
            for (int ww = 0; ww < 8; ++ww) s += ((const LAS float*)&red[(ww * 3 + t) * 64 + sl])[rg];
            lg[row * 48 + n] = s + (n < 4 ? args.in[I_BRG][n] : args.in[I_BRE][n - 4]); }
        __syncthreads();
        if (tid < 16) {
            const LAS float* L = lg + tid * 48; const int tok = grp * 16 + tid;
            int gi = 0; float gm = L[0];
#pragma unroll
            for (int i = 1; i < 4; ++i) if (L[i] > gm) { gm = L[i]; gi = i; }
            float gs = 0.f;
#pragma unroll
            for (int i = 0; i < 4; ++i) gs += expf(L[i] - gm);
            const float pg = 1.0f / gs;
            const LAS float* E = L + 4 + gi * 8;
            int e1 = 0; float l1 = E[0];
#pragma unroll
            for (int i = 1; i < 8; ++i) if (E[i] > l1) { l1 = E[i]; e1 = i; }
            int e2 = -1; float l2 = -INFINITY;
#pragma unroll
            for (int i = 0; i < 8; ++i) if (i != e1 && E[i] > l2) { l2 = E[i]; e2 = i; }
            const float r = expf(l2 - l1), g1 = pg / (1.0f + r), g2 = pg * r / (1.0f + r);
            const int ea = gi * 8 + e1, eb = gi * 8 + e2;
            const unsigned pa = atomicAdd(cnt + 64 * ea, 1u); TL[(size_t)ea * TL_CAP + pa] = tok * 2; GWp[tok * 2] = g1;
            const unsigned pb = atomicAdd(cnt + 64 * eb, 1u); TL[(size_t)eb * TL_CAP + pb] = tok * 2 + 1; GWp[tok * 2 + 1] = g2;
        }
        __syncthreads();
    }
}

__device__ __forceinline__ void ln2_phase(Frame& F, const Args& args) {
    const int lane = F.lane, gw = F.vcu * NWAVES + F.wave, NGW = F.G * NWAVES;
    float* X = (float*)(F.ws + Z_X1); const bf16_t* Y = (const bf16_t*)(F.ws + Z_Y); bf16_t* X2B = (bf16_t*)(F.ws + S2_X2B);
    for (int row = gw; row < T_TOK; row += NGW) {
        float v[32]; float s = 0.f;
#pragma unroll
        for (int i = 0; i < 4; ++i) { const int e0 = i * 512 + lane * 8;
            const f32x4 a = *(const GAS f32x4*)(X + (size_t)row * 2048 + e0), b = *(const GAS f32x4*)(X + (size_t)row * 2048 + e0 + 4);
            const u32x4 y0 = *(const GAS u32x4*)(Y + (size_t)(2 * row) * 2048 + e0), y1 = *(const GAS u32x4*)(Y + (size_t)(2 * row + 1) * 2048 + e0);
            v[8 * i + 0] = ALPHA * a.x + bf_lo(y0.x) + bf_lo(y1.x); v[8 * i + 1] = ALPHA * a.y + bf_hi(y0.x) + bf_hi(y1.x); v[8 * i + 2] = ALPHA * a.z + bf_lo(y0.y) + bf_lo(y1.y); v[8 * i + 3] = ALPHA * a.w + bf_hi(y0.y) + bf_hi(y1.y);
            v[8 * i + 4] = ALPHA * b.x + bf_lo(y0.z) + bf_lo(y1.z); v[8 * i + 5] = ALPHA * b.y + bf_hi(y0.z) + bf_hi(y1.z); v[8 * i + 6] = ALPHA * b.z + bf_lo(y0.w) + bf_lo(y1.w); v[8 * i + 7] = ALPHA * b.w + bf_hi(y0.w) + bf_hi(y1.w); }
#pragma unroll
        for (int i = 0; i < 32; ++i) s += v[i];
        const float mean = wave_sum(s) * (1.0f / 2048.0f); float q = 0.f;
#pragma unroll
        for (int i = 0; i < 32; ++i) { v[i] -= mean; q += v[i] * v[i]; }
        const float rstd = 1.0f / sqrtf(wave_sum(q) * (1.0f / 2048.0f) + LN_EPS);
#pragma unroll
        for (int i = 0; i < 4; ++i) { const int e0 = i * 512 + lane * 8; float y[8];
            const f32x4 g0 = *(const f32x4*)(args.in[I_LN2G] + e0), g1 = *(const f32x4*)(args.in[I_LN2G] + e0 + 4), b0 = *(const f32x4*)(args.in[I_LN2B] + e0), b1 = *(const f32x4*)(args.in[I_LN2B] + e0 + 4);
            y[0] = v[8 * i + 0] * rstd * g0.x + b0.x; y[1] = v[8 * i + 1] * rstd * g0.y + b0.y; y[2] = v[8 * i + 2] * rstd * g0.z + b0.z; y[3] = v[8 * i + 3] * rstd * g0.w + b0.w;
            y[4] = v[8 * i + 4] * rstd * g1.x + b1.x; y[5] = v[8 * i + 5] * rstd * g1.y + b1.y; y[6] = v[8 * i + 6] * rstd * g1.z + b1.z; y[7] = v[8 * i + 7] * rstd * g1.w + b1.w;
            *(GAS f32x4*)(X + (size_t)row * 2048 + e0) = (f32x4){y[0], y[1], y[2], y[3]}; *(GAS f32x4*)(X + (size_t)row * 2048 + e0 + 4) = (f32x4){y[4], y[5], y[6], y[7]};
            u32x4 hi; hi.x = cvt_pk_bf16(y[0], y[1]); hi.y = cvt_pk_bf16(y[2], y[3]); hi.z = cvt_pk_bf16(y[4], y[5]); hi.w = cvt_pk_bf16(y[6], y[7]);
            *(GAS u32x4*)(X2B + (size_t)row * 2048 + e0) = hi; }
    }
}

struct StaticSched {
    static constexpr bool GATHER = false;
    const char* A0; const char* A1; const char* B0; const char* B1; int lda, ldb, nM, nN, nwg, G, c, nseg;
    __device__ __forceinline__ void init(const void* a0, const void* a1, const void* b0, const void* b1, int lda_, int ldb_, int M, int N, int G_, int c_, int nseg_) {
        A0 = (const char*)a0; A1 = (const char*)a1; B0 = (const char*)b0; B1 = (const char*)b1; lda = lda_; ldb = ldb_; nM = M / 256; nN = N / 256; nwg = nM * nN; G = G_; c = c_; nseg = nseg_; }
    __device__ __forceinline__ bool next(int i, pg8::Unit& u) const {
        const int base = (nseg == 2) ? (i >> 1) : i; const long L = (long)base * G + c; if (L >= nwg) return false;
        const int wgid = pg8::xcd_remap((int)L, nwg); pg8::tile_of(wgid, nM, nN, u.pm, u.pn); u.seg = (nseg == 2) ? (i & 1) : 0; u.aux = 0; return true; }
    __device__ __forceinline__ const char* abase(const pg8::Unit& u) const { return (u.seg ? A1 : A0) + (size_t)u.pm * 256 * lda * 2; }
    __device__ __forceinline__ const char* bbase(const pg8::Unit& u) const { return (u.seg ? B1 : B0) + (size_t)u.pn * 256 * ldb * 2; }
    __device__ __forceinline__ void gather(const pg8::Unit&, const int (&)[2], const int (&)[2], unsigned (&)[2][2]) const {}
};
constexpr int LDS_TAB_OFF = RING_BYTES;
template <bool GATHER_>
struct MoeSched {
    static constexpr bool GATHER = GATHER_;
    const LAS int* tstart; const LAS int* cntl; const char* Abase; const char* Bbase; const int* TL; size_t estride; int lda, ldb, NT, nwg, G, c;
    __device__ __forceinline__ bool next(int i, pg8::Unit& u) const {
        const long L = (long)i * G + c; if (L >= nwg) return false;
        const int wgid = pg8::xcd_remap((int)L, nwg); const int rt = wgid / NT; u.pn = wgid % NT; int e = 0;
        while (e < N_EXPERTS - 1 && tstart[e + 1] <= rt) ++e;
        u.pm = rt; u.aux = e; u.seg = rt - tstart[e]; return true; }
    __device__ __forceinline__ const char* abase(const pg8::Unit& u) const { return GATHER ? Abase : Abase + (size_t)u.pm * 256 * lda * 2; }
    __device__ __forceinline__ const char* bbase(const pg8::Unit& u) const { return Bbase + (size_t)u.aux * estride + (size_t)u.pn * 256 * ldb * 2; }
    __device__ __forceinline__ void gather(const pg8::Unit& u, const int (&R)[2], const int (&C)[2], unsigned (&voff)[2][2]) const {
        const int cn = cntl[u.aux];
#pragma unroll
        for (int h = 0; h < 2; ++h)
#pragma unroll
            for (int i = 0; i < 2; ++i) { const int idx = u.seg * 256 + h * 128 + R[i]; int asg = 0; if (idx < cn) asg = TL[(size_t)u.aux * TL_CAP + idx];
                voff[h][i] = (unsigned)(asg >> 1) * (unsigned)(lda * 2) + (unsigned)C[i] * 2u; } }
};

typedef const f32x4 (&AccRef)[2][2][4][2];
__device__ __forceinline__ u32x4 pack8(const f32x4 a, const f32x4 b) { u32x4 w; w.x = cvt_pk_bf16(a.x, a.y); w.y = cvt_pk_bf16(a.z, a.w); w.z = cvt_pk_bf16(b.x, b.y); w.w = cvt_pk_bf16(b.z, b.w); return w; }
__device__ __forceinline__ f32x4 sig4(const f32x4 v) { return (f32x4){sigmoidf_(v.x), sigmoidf_(v.y), sigmoidf_(v.z), sigmoidf_(v.w)}; }
__device__ __forceinline__ f32x4 unpk_lo(const u32x4 u) { return (f32x4){bf_lo(u.x), bf_hi(u.x), bf_lo(u.y), bf_hi(u.y)}; }
__device__ __forceinline__ f32x4 unpk_hi(const u32x4 u) { return (f32x4){bf_lo(u.z), bf_hi(u.z), bf_lo(u.w), bf_hi(u.w)}; }

struct EpiZ {
    static constexpr bool PERM = true; bf16_t* Z; const float* bias;
    __device__ __forceinline__ void operator()(AccRef acc, const pg8::Unit& u, int wr, int wc, int fr, int fq) const {
        const int row0 = u.pm * 256 + wr * 64 + fr, col0 = u.pn * 256 + wc * 32 + 8 * fq, bcol0 = col0 + (u.pn >= 12 ? 8 : 0);
        const bool sg = (u.pn >= 8 && u.pn < 12) || u.pn >= 16;
        f32x4 bv[2][2];
#pragma unroll
        for (int bj = 0; bj < 2; ++bj)
#pragma unroll
            for (int n = 0; n < 2; ++n) bv[bj][n] = *(const f32x4*)(bias + bcol0 + bj * 128 + 4 * n);
#pragma unroll
        for (int ai = 0; ai < 2; ++ai)
#pragma unroll
            for (int m = 0; m < 4; ++m) { bf16_t* rowp = Z + (size_t)(row0 + ai * 128 + m * 16) * ZW + col0;
#pragma unroll
                for (int bj = 0; bj < 2; ++bj) { f32x4 v0 = acc[ai][bj][m][0] + bv[bj][0], v1 = acc[ai][bj][m][1] + bv[bj][1];
                    if (sg) { v0 = sig4(v0); v1 = sig4(v1); }
                    *(GAS u32x4*)(rowp + bj * 128) = pack8(v0, v1); } }
    }
};
struct EpiMerge {
    static constexpr bool PERM = true; const bf16_t* Z; bf16_t* park; bf16_t* merged;
    __device__ __forceinline__ void operator()(AccRef acc, const pg8::Unit& u, int wr, int wc, int fr, int fq) const {
        const int row0 = u.pm * 256 + wr * 64 + fr, col0 = u.pn * 256 + wc * 32 + 8 * fq; const int zc = u.seg ? ZC_GM : ZC_GP;
#pragma unroll
        for (int ai = 0; ai < 2; ++ai)
#pragma unroll
            for (int m = 0; m < 4; ++m) { const size_t r = (size_t)(row0 + ai * 128 + m * 16);
#pragma unroll
                for (int bj = 0; bj < 2; ++bj) { const u32x4 gz = *(const GAS u32x4*)(Z + r * ZW + zc + col0 + bj * 128);
                    f32x4 v0 = acc[ai][bj][m][0] * unpk_lo(gz), v1 = acc[ai][bj][m][1] * unpk_hi(gz);
                    if (u.seg) { const u32x4 pk = *(const GAS u32x4*)(park + r * 2048 + col0 + bj * 128); v0 = v0 + unpk_lo(pk); v1 = v1 + unpk_hi(pk); *(GAS u32x4*)(merged + r * 2048 + col0 + bj * 128) = pack8(v0, v1); }
                    else *(GAS u32x4*)(park + r * 2048 + col0 + bj * 128) = pack8(v0, v1); } }
    }
};
struct EpiHpre {
    static constexpr bool PERM = false; const float* x; float* out;
    __device__ __forceinline__ void operator()(AccRef acc, const pg8::Unit& u, int wr, int wc, int fr, int fq) const {
        const int row0 = u.pm * 256 + wr * 64 + fr, col0 = u.pn * 256 + wc * 32 + 4 * fq;
#pragma unroll
        for (int ai = 0; ai < 2; ++ai)
#pragma unroll
            for (int m = 0; m < 4; ++m) { const size_t off = (size_t)(row0 + ai * 128 + m * 16) * 2048 + col0;
#pragma unroll
                for (int bj = 0; bj < 2; ++bj)
#pragma unroll
                    for (int n = 0; n < 2; ++n) { const f32x4 xv = *(const GAS f32x4*)(x + off + bj * 128 + n * 16); *(GAS f32x4*)(out + off + bj * 128 + n * 16) = xv * ALPHA + acc[ai][bj][m][n]; } }
    }
};
struct EpiHid {
    static constexpr bool PERM = true; bf16_t* hid;
    __device__ __forceinline__ void operator()(AccRef acc, const pg8::Unit& u, int wr, int wc, int fr, int fq) const {
        const int row0 = u.pm * 256 + wr * 64 + fr, col0 = u.pn * 128 + wc * 32 + 8 * fq;
#pragma unroll
        for (int ai = 0; ai < 2; ++ai)
#pragma unroll
            for (int m = 0; m < 4; ++m) { const f32x4 g0 = acc[ai][0][m][0], g1 = acc[ai][0][m][1];
                const f32x4 v0 = g0 * sig4(g0) * acc[ai][1][m][0], v1 = g1 * sig4(g1) * acc[ai][1][m][1];
                *(GAS u32x4*)(hid + (size_t)(row0 + ai * 128 + m * 16) * D_EXPERT + col0) = pack8(v0, v1); }
    }
};
struct EpiY {
    static constexpr bool PERM = true; bf16_t* Y; const int* TL; const float* GWp; const LAS int* cntl;
    __device__ __forceinline__ void operator()(AccRef acc, const pg8::Unit& u, int wr, int wc, int fr, int fq) const {
        const int cn = cntl[u.aux], col0 = u.pn * 256 + wc * 32 + 8 * fq;
#pragma unroll
        for (int ai = 0; ai < 2; ++ai)
#pragma unroll
            for (int m = 0; m < 4; ++m) { const int idx = u.seg * 256 + ai * 128 + wr * 64 + m * 16 + fr;
                if (idx < cn) { const int asg = TL[(size_t)u.aux * TL_CAP + idx]; const float gw = GWp[asg];
#pragma unroll
                    for (int bj = 0; bj < 2; ++bj) *(GAS u32x4*)(Y + (size_t)asg * 2048 + col0 + bj * 128) = pack8(acc[ai][bj][m][0] * gw, acc[ai][bj][m][1] * gw); } }
    }
};
struct EpiPark {
    static constexpr bool PERM = true; bf16_t* park;
    __device__ __forceinline__ void operator()(AccRef acc, const pg8::Unit& u, int wr, int wc, int fr, int fq) const {
        const int row0 = u.pm * 256 + wr * 64 + fr, col0 = u.pn * 256 + wc * 32 + 8 * fq;
#pragma unroll
        for (int ai = 0; ai < 2; ++ai)
#pragma unroll
            for (int m = 0; m < 4; ++m)
#pragma unroll
                for (int bj = 0; bj < 2; ++bj) *(GAS u32x4*)(park + (size_t)(row0 + ai * 128 + m * 16) * 2048 + col0 + bj * 128) = pack8(acc[ai][bj][m][0], acc[ai][bj][m][1]);
    }
};
struct EpiOut {
    static constexpr bool PERM = true; const float* x2; const bf16_t* park; const float* bias; float* out;
    __device__ __forceinline__ void operator()(AccRef acc, const pg8::Unit& u, int wr, int wc, int fr, int fq) const {
        const int row0 = u.pm * 256 + wr * 64 + fr, col0 = u.pn * 256 + wc * 32 + 8 * fq;
        f32x4 bv[2][2];
#pragma unroll
        for (int bj = 0; bj < 2; ++bj)
#pragma unroll
            for (int n = 0; n < 2; ++n) bv[bj][n] = *(const f32x4*)(bias + col0 + bj * 128 + 4 * n);
#pragma unroll
        for (int ai = 0; ai < 2; ++ai)
#pragma unroll
            for (int m = 0; m < 4; ++m) { const size_t off = (size_t)(row0 + ai * 128 + m * 16) * 2048 + col0;
#pragma unroll
                for (int bj = 0; bj < 2; ++bj) { const u32x4 pk = *(const GAS u32x4*)(park + off + bj * 128);
                    const f32x4 x0 = *(const GAS f32x4*)(x2 + off + bj * 128), x1 = *(const GAS f32x4*)(x2 + off + bj * 128 + 4);
                    *(GAS f32x4*)(out + off + bj * 128) = x0 + sig4(acc[ai][bj][m][0] + bv[bj][0]) * unpk_lo(pk);
                    *(GAS f32x4*)(out + off + bj * 128 + 4) = x1 + sig4(acc[ai][bj][m][1] + bv[bj][1]) * unpk_hi(pk); }
                asm volatile("" ::: "memory"); }
    }
};

constexpr int N_PHASES = 12;
__global__ void __launch_bounds__(NTHREADS, 2) mk_fwd(Args args) {
    extern __shared__ __attribute__((aligned(16))) unsigned char lds_raw[];
    Frame F;
    F.lds = (LAS unsigned char*)lds_raw;
    F.tid = threadIdx.x; F.lane = F.tid & 63; F.wave = __builtin_amdgcn_readfirstlane(F.tid >> 6);
    F.G = gridDim.x; { const int bx = blockIdx.x; F.vcu = (F.G % 8 == 0) ? (bx % 8) * (F.G / 8) + bx / 8 : bx; }
    F.ws = args.ws; F.outb = (unsigned char*)args.out;
    volatile LAS unsigned* MISC = (volatile LAS unsigned*)(F.lds + LDS_MISC_OFF);
    if (F.tid < 64) MISC[F.tid] = 0u;
    __syncthreads();
    unsigned* ctl = (unsigned*)(F.ws + WS_CTL);
    XcdBarrier bar; bar.bar = ctl + CW_BAR; bar.x = 0; bar.st = nullptr;
    if (MK_N_LAUNCHES == 1) bar = xcd_barrier_post(ctl + CW_BAR, MISC + 8);
    const int lo = args.ph_lo, hi = args.ph_hi;
#ifndef PH_MASK
#define PH_MASK 0xFFF
#endif
#define IN(k) ((((PH_MASK) >> (k)) & 1) && lo <= (k) && (k) < hi)
#define SEAM(k) do { if (IN(k) && IN((k) + 1)) xcd_barrier(bar); } while (0)
    LAS unsigned char* ring = F.lds;
    const int bid = (int)blockIdx.x;

    if (IN(0)) { p0_prologue(F, args); } SEAM(0);

    if (IN(1)) {
        if (F.vcu < NBH) gate_scan(F, F.vcu);
        StaticSched S; S.init(F.outb + OUT_XB, nullptr, F.ws + W_IN, nullptr, 2048, 2048, T_TOK, ZW, F.G, bid, 1);
        EpiZ E{(bf16_t*)(F.ws + WS_Z), args.in[I_BIN]};
        pg8::gemm_phase<EpiZ, StaticSched>(ring, 2048, 2048, 2048, S, E);
    } SEAM(1);

    if (IN(2)) {
        for (int u = F.vcu; u < NBH * NCHUNK; u += F.G) mlstm_m1_unit(F, args, u >> 5, u & 31);
        pool_phase(F);
    } SEAM(2);

    if (IN(3)) { mlstm_m2(F); } SEAM(3);

    if (IN(4)) { for (int u = F.vcu; u < NBH * NCHUNK; u += F.G) mlstm_m3_unit(F, args, u >> 5, u & 31); } SEAM(4);

    if (IN(5)) {
        StaticSched S; S.init(F.outb + OUT_PU, F.outb + OUT_HG, F.ws + W_EFF, F.ws + W_MBR, 1024, 1024, T_TOK, 2048, F.G, bid, 2);
        EpiMerge E{(const bf16_t*)(F.ws + WS_Z), (bf16_t*)(F.ws + S2_PARK), (bf16_t*)(F.ws + S2_MERGED)};
        pg8::gemm_phase<EpiMerge, StaticSched>(ring, 1024, 1024, 1024, S, E);
    } SEAM(5);

    if (IN(6)) {
        StaticSched S; S.init(F.ws + S2_MERGED, nullptr, F.ws + W_OUT, nullptr, 2048, 2048, T_TOK, 2048, F.G, bid, 1);
        EpiHpre E{args.in[I_X], (float*)(F.ws + Z_X1)};
        pg8::gemm_phase<EpiHpre, StaticSched>(ring, 2048, 2048, 2048, S, E);
    } SEAM(6);

    if (IN(7)) { ln1_router_phase(F, args); } SEAM(7);

    if (IN(8) || IN(9)) {
        LAS int* tstart = (LAS int*)(F.lds + LDS_TAB_OFF); LAS int* cntl = (LAS int*)(F.lds + LDS_TAB_OFF + 256);
        if (F.tid < N_EXPERTS) cntl[F.tid] = (int)__hip_atomic_load(ctl + CW_CNT + 64 * F.tid, RLX_AGENT);
        __syncthreads();
        if (F.tid == 0) { int s = 0; for (int e = 0; e < N_EXPERTS; ++e) { tstart[e] = s; s += (cntl[e] + 255) >> 8; } tstart[N_EXPERTS] = s; }
        __syncthreads();
        const int RT = tstart[N_EXPERTS];
        if (IN(8)) {
            MoeSched<true> S; S.tstart = tstart; S.cntl = cntl; S.Abase = (const char*)(F.ws + S2_X1B); S.Bbase = (const char*)(F.ws + W_GU); S.TL = (const int*)(F.ws + WS_SMALL + SM_TL);
            S.estride = (size_t)1536 * 2048 * 2; S.lda = 2048; S.ldb = 2048; S.NT = 6; S.nwg = RT * 6; S.G = F.G; S.c = bid;
            EpiHid E{(bf16_t*)(F.ws + S2_HID)};
            pg8::gemm_phase<EpiHid, MoeSched<true>>(ring, 2048, 2048, 2048, S, E);
        }
        SEAM(8);
        if (IN(9)) {
            MoeSched<false> S; S.tstart = tstart; S.cntl = cntl; S.Abase = (const char*)(F.ws + S2_HID); S.Bbase = (const char*)(F.ws + W_DN); S.TL = (const int*)(F.ws + WS_SMALL + SM_TL);
            S.estride = (size_t)2048 * 768 * 2; S.lda = 768; S.ldb = 768; S.NT = 8; S.nwg = RT * 8; S.G = F.G; S.c = bid;
            EpiY E{(bf16_t*)(F.ws + Z_Y), (const int*)(F.ws + WS_SMALL + SM_TL), (const float*)(F.ws + WS_SMALL + SM_GW), cntl};
            pg8::gemm_phase<EpiY, MoeSched<false>>(ring, 768, 768, 768, S, E);
        }
    } SEAM(9);

    if (IN(10)) { ln2_phase(F, args); } SEAM(10);

    if (IN(11)) {
        { StaticSched S; S.init(F.ws + WS_PB, nullptr, F.ws + W_PP, nullptr, 256, 256, T_TOK, 2048, F.G, bid, 1);
          EpiPark E{(bf16_t*)(F.ws + S2_PARK2)};
          pg8::gemm_phase<EpiPark, StaticSched>(ring, 256, 256, 256, S, E); }
        { StaticSched S; S.init(F.ws + S2_X2B, nullptr, F.ws + W_PG, nullptr, 2048, 2048, T_TOK, 2048, F.G, bid, 1);
          EpiOut E{(const float*)(F.ws + Z_X1), (const bf16_t*)(F.ws + S2_PARK2), args.in[I_BPG], args.out};
          pg8::gemm_phase<EpiOut, StaticSched>(ring, 2048, 2048, 2048, S, E); }
    }
#undef IN
#undef SEAM
}

extern "C" void kernel_launch(void* const* d_in, const int* in_sizes, int n_in, void* d_out, int out_size, void* d_ws, size_t ws_size, hipStream_t stream) {
    static int grid = 0;
    if (grid == 0) {
        if (n_in != 26 || in_sizes[0] != T_TOK * D_MODEL || out_size != T_TOK * D_MODEL || ws_size < WS_END) { fprintf(stderr, "kernel_launch: unexpected shapes (n_in %d, ws %zu)\n", n_in, ws_size); grid = -1; return; }
        int dev = 0, cus = 0;
        if (hipGetDevice(&dev) != hipSuccess || hipDeviceGetAttribute(&cus, hipDeviceAttributeMultiprocessorCount, dev) != hipSuccess) { grid = -1; return; }
        if (hipFuncSetAttribute((const void*)mk_fwd, hipFuncAttributeMaxDynamicSharedMemorySize, LDS_BYTES) != hipSuccess) { fprintf(stderr, "kernel_launch: hipFuncSetAttribute failed\n"); grid = -1; return; }
        (void)hipGetLastError();
        grid = cus;
    }
    if (grid < 0) return;
    (void)hipMemsetAsync((char*)d_ws + WS_CTL, 0, CTL_ZERO_BYTES, stream);
    Args a{};
    for (int i = 0; i < 26; ++i) a.in[i] = (const float*)d_in[i];
    a.out = (float*)d_out; a.ws = (unsigned char*)d_ws;
    if (MK_N_LAUNCHES == 1) { a.ph_lo = 0; a.ph_hi = N_PHASES; hipLaunchKernelGGL(mk_fwd, dim3(grid), dim3(NTHREADS), LDS_BYTES, stream, a); }
    else for (int li = 0; li < N_PHASES; ++li) { a.ph_lo = li; a.ph_hi = li + 1; hipLaunchKernelGGL(mk_fwd, dim3(grid), dim3(NTHREADS), LDS_BYTES, stream, a); }
}
```

```cpp
#include <hip/hip_runtime.h>
#include <cstdio>
#include <cstdint>

#ifndef MK_N_LAUNCHES
#define MK_N_LAUNCHES 1
#endif

#define GAS __attribute__((address_space(1)))
#define LAS __attribute__((address_space(3)))
typedef unsigned short bf16_t;
typedef short bf16x8 __attribute__((ext_vector_type(8)));
typedef short s16x4 __attribute__((ext_vector_type(4)));
typedef float f32x4 __attribute__((ext_vector_type(4)));
typedef float f32x2 __attribute__((ext_vector_type(2)));
typedef unsigned u32x4 __attribute__((ext_vector_type(4)));
typedef unsigned u32x2 __attribute__((ext_vector_type(2)));

constexpr int D_MODEL = 2048, BATCH = 4, SEQ = 4096, T_TOK = BATCH * SEQ;
constexpr int PLE_DIM = 256, M_HEADS = 4, M_QK_DIM = 128, M_V_DIM = 256, M_QK = 512, M_V = 1024, CHUNK = 128, NCHUNK = SEQ / CHUNK;
constexpr int POOL_W = 1024, IN_DIM = 8200, ZW = 8192;
constexpr int N_EXPERTS = 32, EPG = 8, D_EXPERT = 768, NBH = BATCH * M_HEADS;
constexpr float LN_EPS = 1e-5f;
constexpr float ALPHA = 1.189207115002721f;
constexpr int ZC_QK = 0, ZC_V = 1024, ZC_O = 2048, ZC_U = 3072, ZC_GM = 4096, ZC_GP = 6144;
#ifndef Z8_MASK
#define Z8_MASK 0xFFFF0F00u
#endif
__host__ __device__ constexpr bool z_is8(int pn) { return ((Z8_MASK >> pn) & 1u) != 0; }

__host__ __device__ constexpr size_t tb_off(size_t row, int col, int ntile) { return (((row >> 8) * ntile + (size_t)(col >> 8)) << 16) + ((row & 255) << 8) + (size_t)(col & 255); }
__host__ __device__ constexpr size_t ta_off(size_t row, int col, int nkt) { return (((row >> 8) * nkt + (size_t)(col >> 6)) * 256 + (row & 255)) * 128 + (size_t)(col & 63) * 2; }
constexpr int ZT = 16;

constexpr size_t MiB = 1u << 20;
constexpr size_t WS_CTL = 0, CTL_ZERO_BYTES = 1 * MiB;
constexpr size_t WS_SMALL = 1 * MiB;
constexpr size_t WS_W = 16 * MiB;
constexpr size_t W_IN = WS_W;
constexpr size_t W_EFF = W_IN + 32 * MiB;
constexpr size_t W_MBR = W_EFF + 4 * MiB;
constexpr size_t W_OUT = W_MBR + 4 * MiB;
constexpr size_t W_PG = W_OUT + 8 * MiB;
constexpr size_t W_PBRT = W_PG;
constexpr size_t W_PS = W_PG + 4 * MiB;
constexpr size_t W_PP = W_PG + 8 * MiB;
constexpr size_t W_RT = W_PP + 1 * MiB;
constexpr size_t W_GU = W_RT + 1 * MiB;
constexpr size_t W_DN = W_GU + 96 * MiB;
constexpr size_t W_PG8 = W_DN + 48 * MiB;
constexpr size_t WS_PB = W_PG8 + 4 * MiB;
constexpr size_t WS_Z = WS_PB + 8 * MiB;
constexpr size_t WS_S2 = WS_Z + 256 * MiB;
constexpr size_t W_IN8 = WS_S2 + 128 * MiB;
constexpr size_t WS_XF8 = W_IN8 + 16 * MiB;
constexpr size_t WS_GT = WS_XF8 + 32 * MiB;
constexpr size_t WS_END = WS_GT + 128 * MiB;
constexpr size_t S2_DKV = WS_S2, S2_CST = WS_S2 + 72 * MiB;
constexpr size_t S2_PARK = WS_S2, S2_MERGED = WS_S2 + 64 * MiB;
constexpr size_t S2_X1B = WS_S2, S2_X1F8 = WS_S2 + 64 * MiB, S2_HID = WS_S2 + 96 * MiB;
constexpr size_t S2_X2B = WS_Z, S2_PARK2 = WS_S2 + 64 * MiB;
constexpr size_t Z_X1 = WS_Z, Z_X2F8 = WS_Z + 64 * MiB, Z_Y = WS_Z + 128 * MiB;
constexpr size_t OUT_XB = 0, OUT_PU = 64 * MiB, OUT_HG = 96 * MiB;
constexpr size_t SM_GATES = 0;
constexpr size_t SM_AT = 1 * MiB;
constexpr size_t SM_MR = SM_AT + 256 * 1024;
constexpr size_t SM_EM = SM_MR + 256 * 1024;
constexpr size_t SM_MC = SM_EM + 256 * 1024;
constexpr size_t SM_ML = SM_MC + 4096;
constexpr size_t SM_DEC = SM_ML + 4096;
constexpr size_t SM_GW = 2 * MiB;
constexpr size_t SM_TL = 3 * MiB;
constexpr int TL_CAP = 32768;
static_assert(SM_TL + 4 * MiB <= 15 * MiB, "small region");
constexpr int CW_BAR = 4096;
constexpr int CW_CNT = 16384;

constexpr int RING_BYTES = 131072;
constexpr int LDS_BYTES = 163840;
constexpr int LDS_MISC_OFF = LDS_BYTES - 256;
constexpr int LDS_USABLE = LDS_MISC_OFF;

constexpr int NWAVES = 8, NTHREADS = 512;

#define RLX_AGENT __ATOMIC_RELAXED, __HIP_MEMORY_SCOPE_AGENT
__device__ __forceinline__ unsigned cvt_pk_bf16(float lo, float hi) { unsigned r; asm volatile("v_cvt_pk_bf16_f32 %0, %1, %2" : "=v"(r) : "v"(lo), "v"(hi)); return r; }
__device__ __forceinline__ unsigned pk4_fp8(float a, float b, float c, float d) { int p = __builtin_amdgcn_cvt_pk_fp8_f32(a, b, 0, false); p = __builtin_amdgcn_cvt_pk_fp8_f32(c, d, p, true); return (unsigned)p; }
__device__ __forceinline__ unsigned pk4_u8(const f32x4 v) {
    unsigned p = __builtin_amdgcn_cvt_pk_u8_f32(floorf(v.x * 255.0f + 0.5f), 0, 0u); p = __builtin_amdgcn_cvt_pk_u8_f32(floorf(v.y * 255.0f + 0.5f), 1, p);
    p = __builtin_amdgcn_cvt_pk_u8_f32(floorf(v.z * 255.0f + 0.5f), 2, p); return __builtin_amdgcn_cvt_pk_u8_f32(floorf(v.w * 255.0f + 0.5f), 3, p); }
__device__ __forceinline__ f32x4 un4_u8(unsigned q) { return (f32x4){(float)(q & 0xffu), (float)((q >> 8) & 0xffu), (float)((q >> 16) & 0xffu), (float)(q >> 24)} * (1.0f / 255.0f); }
__device__ __forceinline__ u32x4 pack8(const f32x4 a, const f32x4 b) { u32x4 w; w.x = cvt_pk_bf16(a.x, a.y); w.y = cvt_pk_bf16(a.z, a.w); w.z = cvt_pk_bf16(b.x, b.y); w.w = cvt_pk_bf16(b.z, b.w); return w; }
__device__ __forceinline__ float bf_lo(unsigned w) { return __uint_as_float(w << 16); }
__device__ __forceinline__ float bf_hi(unsigned w) { return __uint_as_float(w & 0xffff0000u); }
__device__ __forceinline__ f32x4 unpk_lo(const u32x4 u) { return (f32x4){bf_lo(u.x), bf_hi(u.x), bf_lo(u.y), bf_hi(u.y)}; }
__device__ __forceinline__ f32x4 unpk_hi(const u32x4 u) { return (f32x4){bf_lo(u.z), bf_hi(u.z), bf_lo(u.w), bf_hi(u.w)}; }
__device__ __forceinline__ float bf2f(bf16_t h) { return __uint_as_float(((unsigned)h) << 16); }
__device__ __forceinline__ float fast_exp(float x) { return __builtin_amdgcn_exp2f(x * 1.44269504088896f); }
__device__ __forceinline__ float sigmoidf_(float x) { return __builtin_amdgcn_rcpf(1.0f + fast_exp(-x)); }
__device__ __forceinline__ float wave_sum(float v) {
#pragma unroll
    for (int o = 1; o < 64; o <<= 1) v += __shfl_xor(v, o);
    return v;
}

#define XB_TMO      128
#define XB_XCNT(j)  (256  + 64 * (j))
#define XB_XSUB(j)  (1280 + 64 * (j))
#define XB_XGEN(j)  (2304 + 64 * (j))
#define XB_TOP      3328
#define XB_TOPGEN   3392
#define XCD_BAR_WORDS 3456
#define XB_SPIN_CAP (1u << 20)
__device__ __forceinline__ unsigned xb_ld(unsigned* p)              { return __hip_atomic_load(p, __ATOMIC_RELAXED, __HIP_MEMORY_SCOPE_AGENT); }
__device__ __forceinline__ unsigned xb_add(unsigned* p, unsigned v) { return __hip_atomic_fetch_add(p, v, __ATOMIC_RELAXED, __HIP_MEMORY_SCOPE_AGENT); }
__device__ __forceinline__ unsigned xb_xcc_id() { return (unsigned)__builtin_amdgcn_s_getreg((3 << 11) | 20) & 0xFu; }
#define XB_SPIN(cond, bar) do { unsigned _sp = 0; while (cond) { __builtin_amdgcn_s_sleep(1); \
    if ((++_sp & 255u) == 0u) { if (xb_ld(&(bar)[XB_TMO])) break; if (_sp > XB_SPIN_CAP) { atomicAdd(&(bar)[XB_TMO], 1u); break; } } } } while (0)
struct XcdBarrier { unsigned* bar; unsigned x; volatile LAS unsigned* st; };
__device__ __forceinline__ XcdBarrier xcd_barrier_post(unsigned* bar, volatile LAS unsigned* st) {
    XcdBarrier b; b.bar = bar; b.x = xb_xcc_id(); b.st = st;
    if (threadIdx.x == 0) (void)xb_add(&bar[XB_XCNT(b.x)], 1u);
    return b;
}
__device__ __forceinline__ void xcd_barrier_complete(unsigned* bar, unsigned x, unsigned& nloc, unsigned& nx) {
    const unsigned G = gridDim.x * gridDim.y * gridDim.z;
    unsigned sum, cnt, mine, sp = 0u;
    for (;;) {
        sum = 0u; cnt = 0u; mine = 0u;
#pragma unroll
        for (unsigned j = 0; j < 16; ++j) { const unsigned c = xb_ld(&bar[XB_XCNT(j)]); sum += c; cnt += (c > 0u) ? 1u : 0u; mine = (j == x) ? c : mine; }
        if (sum == G) break;
        __builtin_amdgcn_s_sleep(1);
        if ((++sp & 255u) == 0u) { if (xb_ld(&bar[XB_TMO])) break; if (sp > XB_SPIN_CAP) { atomicAdd(&bar[XB_TMO], 1u); break; } }
    }
    nloc = mine > 0u ? mine : 1u; nx = cnt > 0u ? cnt : 1u;
}
__device__ __forceinline__ void xcd_barrier(const XcdBarrier& b) {
    asm volatile("s_waitcnt vmcnt(0)" ::: "memory");
    __syncthreads();
    if (threadIdx.x == 0) {
        unsigned* bar = b.bar;
        __builtin_amdgcn_s_waitcnt(0);
        unsigned nloc = b.st[0], nx = b.st[1];
        if (nloc == 0u) { xcd_barrier_complete(bar, b.x, nloc, nx); b.st[0] = nloc; b.st[1] = nx; }
        const unsigned old = xb_add(&bar[XB_XSUB(b.x)], 1u);
        const unsigned gen = old / nloc;
        if (old + 1u == (gen + 1u) * nloc) {
            __builtin_amdgcn_fence(__ATOMIC_RELEASE, "agent");
            asm volatile("s_waitcnt vmcnt(0)" ::: "memory");
            const unsigned og = xb_add(&bar[XB_TOP], 1u);
            const unsigned tg = og / nx;
            if (og + 1u == (tg + 1u) * nx) xb_add(&bar[XB_TOPGEN], 1u);
            else XB_SPIN(xb_ld(&bar[XB_TOPGEN]) == tg, bar);
            __builtin_amdgcn_fence(__ATOMIC_ACQUIRE, "agent");
            xb_add(&bar[XB_XGEN(b.x)], 1u);
            asm volatile("s_waitcnt vmcnt(0)" ::: "memory");
        } else {
            XB_SPIN(xb_ld(&bar[XB_XGEN(b.x)]) == gen, bar);
            __builtin_amdgcn_fence(__ATOMIC_ACQUIRE, "agent");
            asm volatile("s_waitcnt vmcnt(0)" ::: "memory");
        }
    }
    __syncthreads();
}

namespace pg8 {
constexpr int BM = 256, BK = 64, HALF = 128, HTB = HALF * BK * 2, STAGE_BYTES = 8 * HTB, NXCD = 8, WGM = 8;
__host__ __device__ __forceinline__ int lds_byte(int r, int c) { const int st = (r >> 4) * 2 + (c >> 5), rr = r & 15, cc = c & 31, ob = rr * 64 + cc * 2; return st * 1024 + (ob ^ (((ob >> 9) & 1) << 5)); }
__host__ __device__ __forceinline__ void stage_rc(int b, int& R, int& C) { const int st = b / 1024, sb = b % 1024, swz = sb ^ (((sb >> 9) & 1) << 5); R = (st >> 1) * 16 + swz / 64; C = (st & 1) * 32 + (swz % 64) / 2; }
__host__ __device__ __forceinline__ int perm32(int rho) { const int n = rho >> 4, i = rho & 15; return 8 * (i >> 2) + 4 * n + (i & 3); }

typedef int i32x8 __attribute__((ext_vector_type(8)));
typedef int i32x4 __attribute__((ext_vector_type(4)));
__device__ __forceinline__ bf16x8 lo8(const i32x8 v) { return __builtin_bit_cast(bf16x8, (i32x4){v[0], v[1], v[2], v[3]}); }
__device__ __forceinline__ bf16x8 hi8(const i32x8 v) { return __builtin_bit_cast(bf16x8, (i32x4){v[4], v[5], v[6], v[7]}); }
struct Unit { int pm, pn, seg, aux; };

__device__ __forceinline__ int xcd_remap(int wgid, int nwg) { const int q = nwg / NXCD, r = nwg % NXCD, xcd = wgid % NXCD, off = wgid / NXCD; return (xcd < r ? xcd * (q + 1) : r * (q + 1) + (xcd - r) * q) + off; }
__device__ __forceinline__ void tile_of(int wgid, int nM, int nN, int& pm, int& pn) { const int nig = WGM * nN, gid = wgid / nig, fm = gid * WGM, gsz = (nM - fm) < WGM ? (nM - fm) : WGM; pm = fm + ((wgid % nig) % gsz); pn = (wgid % nig) / gsz; }

template <class Epi, class Sched, bool FP8 = false, bool ATILED = false>
__device__ __forceinline__ void gemm_phase(LAS unsigned char* lds, const int K, const int lda, const int ldb, const Sched& S, const Epi& E) {
    const int tid = threadIdx.x, wid = __builtin_amdgcn_readfirstlane(tid >> 6), lane = tid & 63, wr = wid >> 2, wc = wid & 3, fr = lane & 15, fq = lane >> 4;
    const int nt = K / BK;
    int Rr[2], Cc[2];
    unsigned voffA[2], voffB[2];
#pragma unroll
    for (int i = 0; i < 2; ++i) { int R, C; stage_rc(tid * 16 + i * 8192, R, C); Rr[i] = R; Cc[i] = C; const int Rb = Epi::PERM ? ((R & ~31) + perm32(R & 31)) : R;
        voffA[i] = ATILED ? (unsigned)(R * 128 + C * 2) : (unsigned)(R * lda + C) * 2u; voffB[i] = (unsigned)(Rb * 128 + C * 2); }
    const size_t kstep = ATILED ? (size_t)32768 : (size_t)(BK * 2);
    const size_t hstepA = ATILED ? (size_t)HALF * 128 : (size_t)HALF * lda * 2, hstepB = (size_t)HALF * 128, kstepB = 32768; (void)ldb;
    const unsigned ldsw = (unsigned)wid * 1024u;
    const int aoff = lds_byte(wr * 64 + fr, fq * 8), boff = lds_byte(wc * 32 + fr, fq * 8);
#define PG8_SA(b, h) (((b) * 2 + (h)) * HTB)
#define PG8_SB(b, h) ((4 + (b) * 2 + (h)) * HTB)
#define PG8_STAGE(bufoff, gbase, voff) do { _Pragma("unroll") for (int _i = 0; _i < 2; ++_i) \
        __builtin_amdgcn_global_load_lds((const unsigned*)((const char*)(gbase) + (voff)[_i]), (LAS unsigned*)(lds + (bufoff) + ldsw + _i * 8192), 16, 0, 0); } while (0)
#define PG8_STAGE_A(bufoff, p, h, vo) do { if constexpr (Sched::GATHER) { PG8_STAGE(bufoff, p, (vo)[h]); } else { PG8_STAGE(bufoff, (p) + (h) * hstepA, voffA); } } while (0)
#define PG8_LDA(dst, b, h) do { _Pragma("unroll") for (int m = 0; m < 4; ++m) { const i32x4 _lo = *(const LAS i32x4*)(lds + PG8_SA(b, h) + aoff + m * 2048), _hi = *(const LAS i32x4*)(lds + PG8_SA(b, h) + aoff + m * 2048 + 1024); \
        dst[m] = (i32x8){_lo[0], _lo[1], _lo[2], _lo[3], _hi[0], _hi[1], _hi[2], _hi[3]}; } } while (0)
#define PG8_LDB(dst, b, h) do { _Pragma("unroll") for (int n = 0; n < 2; ++n) { const i32x4 _lo = *(const LAS i32x4*)(lds + PG8_SB(b, h) + boff + n * 2048), _hi = *(const LAS i32x4*)(lds + PG8_SB(b, h) + boff + n * 2048 + 1024); \
        dst[n] = (i32x8){_lo[0], _lo[1], _lo[2], _lo[3], _hi[0], _hi[1], _hi[2], _hi[3]}; } } while (0)
#define PG8_MMA(ai, bj, At, Bt) do { __builtin_amdgcn_s_setprio(1); _Pragma("unroll") for (int m = 0; m < 4; ++m) _Pragma("unroll") for (int n = 0; n < 2; ++n) { \
        if constexpr (FP8) { asm volatile("v_mfma_scale_f32_16x16x128_f8f6f4 %0, %1, %2, %0, %3, %3 op_sel_hi:[0,0,0]" : "+v"(acc[ai][bj][m][n]) : "v"(Bt[n]), "v"(At[m]), "v"(scale1)); } \
        else { acc[ai][bj][m][n] = __builtin_amdgcn_mfma_f32_16x16x32_bf16(lo8(Bt[n]), lo8(At[m]), acc[ai][bj][m][n], 0, 0, 0); acc[ai][bj][m][n] = __builtin_amdgcn_mfma_f32_16x16x32_bf16(hi8(Bt[n]), hi8(At[m]), acc[ai][bj][m][n], 0, 0, 0); } } __builtin_amdgcn_s_setprio(0); } while (0)
#define PG8_WAIT_V(n) asm volatile("s_waitcnt vmcnt(" #n ")" ::: "memory")
#define PG8_WAIT_L(n) asm volatile("s_waitcnt lgkmcnt(" #n ")" ::: "memory")
#define PG8_BAR __builtin_amdgcn_s_barrier()
#define PG8_SCHED __builtin_amdgcn_sched_barrier(0)
    Unit cur, nxt; int ui = 0;
    if (!S.next(0, cur)) return;
    const int scale1 = 0x7f7f7f7f;
    f32x4 acc[2][2][4][2];
#pragma unroll
    for (int a = 0; a < 2; ++a)
#pragma unroll
        for (int b = 0; b < 2; ++b)
#pragma unroll
            for (int m = 0; m < 4; ++m)
#pragma unroll
                for (int n = 0; n < 2; ++n) acc[a][b][m][n] = (f32x4){0.f, 0.f, 0.f, 0.f};
    i32x8 At[4], B0[2], B1[2];
    unsigned vgc[2][2], vgn[2][2];
    const char* cA = S.abase(cur); const char* cB = S.bbase(cur);
    if constexpr (Sched::GATHER) { S.gather(cur, Rr, Cc, vgc); }
    PG8_STAGE(PG8_SB(0, 0), cB, voffB); PG8_STAGE(PG8_SB(0, 1), cB + hstepB, voffB); PG8_STAGE_A(PG8_SA(0, 0), cA, 0, vgc); PG8_STAGE_A(PG8_SA(0, 1), cA, 1, vgc);
    if (wr == 1) PG8_BAR;
    PG8_WAIT_V(2); PG8_BAR;
    PG8_STAGE(PG8_SB(1, 0), cB + kstepB, voffB); PG8_STAGE_A(PG8_SA(1, 0), cA + kstep, 0, vgc); PG8_STAGE(PG8_SB(1, 1), cB + hstepB + kstepB, voffB);
    PG8_WAIT_V(6); PG8_BAR;
    for (;;) {
        const bool has_next = S.next(ui + 1, nxt);
        const char* nA = has_next ? S.abase(nxt) : cA; const char* nB = has_next ? S.bbase(nxt) : cB;
        if constexpr (Sched::GATHER) { if (has_next) S.gather(nxt, Rr, Cc, vgn); else {
#pragma unroll
            for (int h = 0; h < 2; ++h)
#pragma unroll
                for (int i = 0; i < 2; ++i) vgn[h][i] = vgc[h][i]; } }
#pragma unroll 1
        for (int t = 0; t < nt; t += 2) {
            const bool last = (t == nt - 2);
            const char* a1 = cA + (size_t)(t + 1) * kstep;
            const char* a2 = last ? nA : cA + (size_t)(t + 2) * kstep; const char* b2 = last ? nB : cB + (size_t)(t + 2) * kstepB;
            const char* a3 = a2 + kstep; const char* b3 = b2 + kstepB;
            unsigned vg2[2][2];
            if constexpr (Sched::GATHER) {
#pragma unroll
                for (int h = 0; h < 2; ++h)
#pragma unroll
                    for (int i = 0; i < 2; ++i) vg2[h][i] = last ? vgn[h][i] : vgc[h][i]; }
            PG8_LDB(B0, 0, 0); PG8_LDB(B1, 0, 1); PG8_SCHED; PG8_LDA(At, 0, 0); PG8_STAGE_A(PG8_SA(1, 1), a1, 1, vgc);
            PG8_WAIT_V(8); PG8_WAIT_L(0); PG8_BAR; PG8_MMA(0, 0, At, B0); PG8_MMA(0, 1, At, B1); PG8_BAR; PG8_SCHED;
            PG8_LDA(At, 0, 1); PG8_STAGE(PG8_SB(0, 0), b2, voffB); PG8_STAGE(PG8_SB(0, 1), b2 + hstepB, voffB); PG8_STAGE_A(PG8_SA(0, 0), a2, 0, vg2);
            PG8_WAIT_V(8); PG8_WAIT_L(0); PG8_BAR; PG8_MMA(1, 0, At, B0); PG8_MMA(1, 1, At, B1); PG8_BAR; PG8_SCHED;
            PG8_LDB(B0, 1, 0); PG8_LDB(B1, 1, 1); PG8_SCHED; PG8_LDA(At, 1, 0); PG8_STAGE_A(PG8_SA(0, 1), a2, 1, vg2);
            PG8_WAIT_V(8); PG8_WAIT_L(0); PG8_BAR; PG8_MMA(0, 0, At, B0); PG8_MMA(0, 1, At, B1); PG8_BAR; PG8_SCHED;
            PG8_LDA(At, 1, 1); PG8_STAGE(PG8_SB(1, 0), b3, voffB); PG8_STAGE(PG8_SB(1, 1), b3 + hstepB, voffB); PG8_STAGE_A(PG8_SA(1, 0), a3, 0, vg2);
            PG8_WAIT_V(8); PG8_WAIT_L(0); PG8_BAR; PG8_MMA(1, 0, At, B0); PG8_MMA(1, 1, At, B1); PG8_BAR; PG8_SCHED;
        }
        if (wr == 0) PG8_BAR;
        if constexpr (FP8) { asm volatile("s_nop 15\n\ts_nop 15" ::: "memory"); }
        E(acc, cur, wr, wc, fr, fq);
        if (!has_next) break;
#pragma unroll
        for (int a = 0; a < 2; ++a)
#pragma unroll
            for (int b = 0; b < 2; ++b)
#pragma unroll
                for (int m = 0; m < 4; ++m)
#pragma unroll
                    for (int n = 0; n < 2; ++n) acc[a][b][m][n] = (f32x4){0.f, 0.f, 0.f, 0.f};
        cur = nxt; cA = nA; cB = nB; ++ui;
        if constexpr (Sched::GATHER) {
#pragma unroll
            for (int h = 0; h < 2; ++h)
#pragma unroll
                for (int i = 0; i < 2; ++i) vgc[h][i] = vgn[h][i]; }
        if (wr == 1) PG8_BAR;
    }
    PG8_WAIT_V(0);
    PG8_BAR;
#undef PG8_SA
#undef PG8_SB
#undef PG8_STAGE
#undef PG8_STAGE_A
#undef PG8_LDA
#undef PG8_LDB
#undef PG8_MMA
#undef PG8_WAIT_V
#undef PG8_WAIT_L
#undef PG8_BAR
#undef PG8_SCHED
}
}

struct Args { const float* in[26]; float* out; unsigned char* ws; int ph_lo, ph_hi; };
enum { I_X = 0, I_P, I_WIN, I_BIN, I_CONVW, I_CONVB, I_MHG, I_WPOOL, I_PSCALE, I_WMBR, I_WPBR, I_WOUT, I_LN1G, I_LN1B, I_WRG, I_BRG, I_WRE, I_BRE, I_WGATE, I_WUP, I_WDOWN, I_LN2G, I_LN2B, I_WPG, I_BPG, I_WPP };

struct Frame {
    LAS unsigned char* lds;
    int tid, lane, wave, vcu, G;
    unsigned char* ws; unsigned char* outb;
};

struct TStep { const float* src; int ldw; unsigned char* dst; int nkt, f8, ks, drow0, inter, nks; };
__device__ __forceinline__ void tstep_decode(const Args& args, unsigned char* ws, int g, TStep& t) {
    constexpr int C1 = 32 * 64, C2 = C1 + 8 * 32, C3 = C2 + 8 * 64, C4 = C3 + 8 * 64, C5 = C4 + 8 * 8, C6 = C5 + 96 * 64, C7 = C6 + 96 * 64, C8 = C7 + 256 * 24;
    t.inter = 0; t.f8 = 0; t.nks = 64;
    if (g < C1) { const int sp = g >> 6, ks = g & 63; t.ks = ks; t.src = args.in[I_WIN] + (size_t)(32 * ks) * IN_DIM + 256 * sp + (sp >= 12 ? 8 : 0); t.ldw = IN_DIM; t.drow0 = 256 * sp;
        if (z_is8(sp)) { t.f8 = 1; t.dst = ws + W_IN8; t.nkt = 16; } else { t.dst = ws + W_IN; t.nkt = 32; } }
    else if (g < C2) { const int q = g - C1, sp = q >> 5, ks = q & 31; t.ks = ks; t.nks = 32; t.src = args.in[I_WMBR] + (size_t)(32 * ks) * 2048 + 256 * sp; t.ldw = 2048; t.dst = ws + W_MBR; t.nkt = 16; t.drow0 = 256 * sp; }
    else if (g < C3) { const int q = g - C2, sp = q >> 6, ks = q & 63; t.ks = ks; t.src = args.in[I_WOUT] + (size_t)(32 * ks) * 2048 + 256 * sp; t.ldw = 2048; t.dst = ws + W_OUT; t.nkt = 32; t.drow0 = 256 * sp; }
    else if (g < C4) { const int q = g - C3, sp = q >> 6, ks = q & 63; t.ks = ks; t.src = args.in[I_WPG] + (size_t)(32 * ks) * 2048 + 256 * sp; t.ldw = 2048; t.dst = ws + W_PG8; t.nkt = 16; t.drow0 = 256 * sp; t.f8 = 1; }
    else if (g < C5) { const int q = g - C4, sp = q >> 3, ks = q & 7; t.ks = ks; t.nks = 8; t.src = args.in[I_WPP] + (size_t)(32 * ks) * 2048 + 256 * sp; t.ldw = 2048; t.dst = ws + W_PP; t.nkt = 4; t.drow0 = 256 * sp; }
    else if (g < C7) { const int up = g >= C6, q = g - (up ? C6 : C5), st = q >> 6, ks = q & 63, e = st / 3, sp = st % 3; t.ks = ks;
        t.src = args.in[up ? I_WUP : I_WGATE] + (size_t)e * 2048 * 768 + (size_t)(32 * ks) * 768 + 256 * sp; t.ldw = 768; t.dst = ws + W_GU; t.nkt = 16; t.drow0 = e * 1536 + (up ? 128 : 0); t.inter = 1 + sp; t.f8 = 1; }
    else if (g < C8) { const int q = g - C7, st = q / 24, ks = q % 24, e = st >> 3, sp = st & 7; t.ks = ks; t.nks = 24;
        t.src = args.in[I_WDOWN] + (size_t)e * 768 * 2048 + (size_t)(32 * ks) * 2048 + 256 * sp; t.ldw = 2048; t.dst = ws + W_DN; t.nkt = 6; t.drow0 = e * 2048 + 256 * sp; t.f8 = 1; }
    else { const int q = g - C8, sp = q >> 5, ks = q & 31; t.ks = ks; t.nks = 32; t.src = args.in[I_WPBR] + (size_t)(32 * ks) * 2048 + 256 * sp; t.ldw = 2048; t.dst = ws + W_PBRT; t.nkt = 16; t.drow0 = 256 * sp; }
}
constexpr int TSTEPS = 32 * 64 + 8 * 32 + 8 * 64 + 8 * 64 + 8 * 8 + 96 * 64 * 2 + 256 * 24 + 8 * 32;
constexpr int TSTEPS_P0 = 32 * 64;
constexpr float W8_SCALE = 64.0f, A8_SCALE = 16.0f, INV8 = 1.0f / (64.0f * 16.0f);
constexpr int TS_NSLOT = 7, TS_SLOTB = 16384, TS_STAGE = TS_NSLOT * TS_SLOTB, TS_RSTRIDE = 144;
static_assert(TS_STAGE + 256 * TS_RSTRIDE <= LDS_USABLE, "transposer LDS map");
template <bool F8>
__device__ __forceinline__ void transpose_segment(const TStep& t, const int nst, LAS unsigned char* lds, int wave, int lane, int tid) {
    const int nh = 2 * nst;
    const float* psrc = t.src + (size_t)wave * t.ldw + 4 * lane;
    const size_t hstep = (size_t)16 * t.ldw, r8 = (size_t)8 * t.ldw;
    int islot = 0;
#pragma unroll 1
    for (int p = 0; p < TS_NSLOT - 1; ++p) if (p < nh) {
        __builtin_amdgcn_global_load_lds((const unsigned*)psrc, (LAS unsigned*)(lds + islot * TS_SLOTB + wave * 1024), 16, 0, 0);
        __builtin_amdgcn_global_load_lds((const unsigned*)(psrc + r8), (LAS unsigned*)(lds + islot * TS_SLOTB + (wave + 8) * 1024), 16, 0, 0);
        psrc += hstep; islot = islot == TS_NSLOT - 1 ? 0 : islot + 1; }
    const int nl = lane >> 1, kq = lane & 1, n = 32 * wave + nl;
    constexpr int GS = F8 ? 8 : 4, SEG = 128 / GS;
    const LAS float* rd = (const LAS float*)lds + n + 8 * kq * 256;
    LAS unsigned char* st = lds + TS_STAGE + n * TS_RSTRIDE + kq * (SEG / 2);
    int slot = 0, sub = (2 * t.ks) & (GS - 1), kt = (2 * t.ks) / GS;
#pragma unroll 1
    for (int h = 0; h < nh; ++h) {
        const int later = (nh - 1 - h) < (TS_NSLOT - 2) ? (nh - 1 - h) : (TS_NSLOT - 2);
        if (later >= 5) asm volatile("s_waitcnt vmcnt(10)" ::: "memory"); else if (later == 4) asm volatile("s_waitcnt vmcnt(8)" ::: "memory"); else if (later == 3) asm volatile("s_waitcnt vmcnt(6)" ::: "memory");
        else if (later == 2) asm volatile("s_waitcnt vmcnt(4)" ::: "memory"); else if (later == 1) asm volatile("s_waitcnt vmcnt(2)" ::: "memory"); else asm volatile("s_waitcnt vmcnt(0)" ::: "memory");
        __builtin_amdgcn_s_barrier(); asm volatile("" ::: "memory");
        if (h + TS_NSLOT - 1 < nh) {
            __builtin_amdgcn_global_load_lds((const unsigned*)psrc, (LAS unsigned*)(lds + islot * TS_SLOTB + wave * 1024), 16, 0, 0);
            __builtin_amdgcn_global_load_lds((const unsigned*)(psrc + r8), (LAS unsigned*)(lds + islot * TS_SLOTB + (wave + 8) * 1024), 16, 0, 0);
            psrc += hstep; islot = islot == TS_NSLOT - 1 ? 0 : islot + 1; }
        const LAS float* sl = rd + slot * (TS_SLOTB / 4);
        float v[8];
#pragma unroll
        for (int j = 0; j < 8; ++j) v[j] = sl[j * 256];
        if (F8) { u32x2 o; o.x = pk4_fp8(v[0] * W8_SCALE, v[1] * W8_SCALE, v[2] * W8_SCALE, v[3] * W8_SCALE); o.y = pk4_fp8(v[4] * W8_SCALE, v[5] * W8_SCALE, v[6] * W8_SCALE, v[7] * W8_SCALE);
            *(LAS u32x2*)(st + sub * SEG) = o; }
        else { u32x4 o; o.x = cvt_pk_bf16(v[0], v[1]); o.y = cvt_pk_bf16(v[2], v[3]); o.z = cvt_pk_bf16(v[4], v[5]); o.w = cvt_pk_bf16(v[6], v[7]);
            *(LAS u32x4*)(st + sub * SEG) = o; }
        if (sub == GS - 1) {
            asm volatile("s_waitcnt lgkmcnt(0)" ::: "memory"); __builtin_amdgcn_s_barrier(); asm volatile("" ::: "memory");
#pragma unroll
            for (int i = 0; i < 4; ++i) { const int c = tid + 512 * i, row = c >> 3, ch = c & 7;
                int drow = t.drow0 + row; if (t.inter) { const int nn = 256 * (t.inter - 1) + row; drow = t.drow0 + (nn >> 7) * 256 + (nn & 127); }
                const u32x4 vv = *(const LAS u32x4*)(lds + TS_STAGE + row * TS_RSTRIDE + ch * 16);
                *(GAS u32x4*)(t.dst + ((size_t)((drow >> 8) * t.nkt + kt) * 256 + (drow & 255)) * 128 + ch * 16) = vv; }
            sub = 0; ++kt;
        } else ++sub;
        slot = slot == TS_NSLOT - 1 ? 0 : slot + 1;
    }
    asm volatile("s_waitcnt vmcnt(0) lgkmcnt(0)" ::: "memory");
    __builtin_amdgcn_s_barrier(); asm volatile("" ::: "memory");
}
__device__ __forceinline__ void transpose_range(Frame& F, const Args& args, const int g0, const int g1) {
    unsigned char* ws = F.ws;
#pragma unroll 1
    for (int g = g0; g < g1;) {
        TStep t; tstep_decode(args, ws, g, t);
        const int nst = (t.nks - t.ks) < (g1 - g) ? (t.nks - t.ks) : (g1 - g);
        if (t.f8) transpose_segment<true>(t, nst, F.lds, F.wave, F.lane, F.tid); else transpose_segment<false>(t, nst, F.lds, F.wave, F.lane, F.tid);
        g += nst;
    }
    __syncthreads();
}

__device__ __forceinline__ void p0_prologue(Frame& F, const Args& args) {
    unsigned char* ws = F.ws;
    const int gw = F.vcu * NWAVES + F.wave, NGW = F.G * NWAVES;
    { const int q0 = (int)(((long)(TSTEPS_P0 / 4) * F.vcu) / F.G) * 4, q1 = (int)(((long)(TSTEPS_P0 / 4) * (F.vcu + 1)) / F.G) * 4; transpose_range(F, args, q0, q1); }
    {
        const float* wpool = args.in[I_WPOOL]; const float* ps = args.in[I_PSCALE]; unsigned char* wps = ws + W_PS;
        const int gt = F.vcu * NTHREADS + F.tid, NGT = F.G * NTHREADS;
        for (int idx = gt; idx < 4 * 256 * 32; idx += NGT) {
            const int d0 = (idx & 31) * 8, kk = (idx >> 5) & 255, g = idx >> 13;
            const f32x4 w0 = *(const f32x4*)(wpool + ((size_t)g * 256 + kk) * 256 + d0), w1 = *(const f32x4*)(wpool + ((size_t)g * 256 + kk) * 256 + d0 + 4);
            const f32x4 p0 = *(const f32x4*)(ps + g * 256 + d0), p1 = *(const f32x4*)(ps + g * 256 + d0 + 4);
            *(GAS u32x4*)(wps + ((size_t)(g * 4 + (d0 >> 6)) * 256 + kk) * 128 + (d0 & 63) * 2) = pack8(w0 * p0, w1 * p1);
        }
    }
    {
        bf16_t* wr = (bf16_t*)(ws + W_RT);
        const int gt = F.vcu * NTHREADS + F.tid, NGT = F.G * NTHREADS;
        for (int idx = gt; idx < 48 * 2048; idx += NGT) { const int n = idx >> 11, k = idx & 2047;
            float w = 0.f; if (n < 4) w = args.in[I_WRG][k * 4 + n]; else if (n < 36) w = args.in[I_WRE][k * 32 + (n - 4)];
            const unsigned hi = cvt_pk_bf16(w, 0.f) & 0xffffu; const float lo = w - __uint_as_float(hi << 16);
            wr[idx] = (bf16_t)hi; wr[48 * 2048 + idx] = (bf16_t)(cvt_pk_bf16(lo, 0.f) & 0xffffu); }
        const f32x4* p4 = (const f32x4*)args.in[I_P]; u32x2* pb = (u32x2*)(ws + WS_PB);
        for (int idx = gt; idx < T_TOK * PLE_DIM / 4; idx += NGT) { const f32x4 v = p4[idx]; u32x2 o; o.x = cvt_pk_bf16(v.x, v.y); o.y = cvt_pk_bf16(v.z, v.w); pb[idx] = o; }
    }
    {
        __syncthreads();
        LAS float* wg = (LAS float*)F.lds;
        for (int idx = F.tid; idx < 8 * 2048; idx += NTHREADS) { const int e = idx >> 3, c = idx & 7; wg[c * 2048 + e] = args.in[I_WIN][(size_t)e * IN_DIM + 3072 + c]; }
        __syncthreads();
        const float* x = args.in[I_X]; bf16_t* xb = (bf16_t*)(F.outb + OUT_XB); float* gates = (float*)(ws + WS_SMALL + SM_GATES);
        for (int row = gw; row < T_TOK; row += NGW) {
            float g[8];
#pragma unroll
            for (int c = 0; c < 8; ++c) g[c] = 0.f;
#pragma unroll
            for (int itx = 0; itx < 4; ++itx) {
                const int e0 = itx * 512 + F.lane * 8;
                const f32x4 v0 = *(const GAS f32x4*)(x + (size_t)row * 2048 + e0), v1 = *(const GAS f32x4*)(x + (size_t)row * 2048 + e0 + 4);
                u32x4 o; o.x = cvt_pk_bf16(v0.x, v0.y); o.y = cvt_pk_bf16(v0.z, v0.w); o.z = cvt_pk_bf16(v1.x, v1.y); o.w = cvt_pk_bf16(v1.z, v1.w);
                *(GAS u32x4*)(xb + (size_t)row * 2048 + e0) = o;
                { u32x2 f8; f8.x = pk4_fp8(v0.x * A8_SCALE, v0.y * A8_SCALE, v0.z * A8_SCALE, v0.w * A8_SCALE); f8.y = pk4_fp8(v1.x * A8_SCALE, v1.y * A8_SCALE, v1.z * A8_SCALE, v1.w * A8_SCALE); *(GAS u32x2*)(ws + WS_XF8 + (size_t)row * 2048 + e0) = f8; }
#pragma unroll
                for (int c = 0; c < 8; ++c) { const f32x4 w0 = *(const LAS f32x4*)(wg + c * 2048 + e0), w1 = *(const LAS f32x4*)(wg + c * 2048 + e0 + 4);
                    g[c] += (v0.x * w0.x + v0.y * w0.y) + (v0.z * w0.z + v0.w * w0.w) + (v1.x * w1.x + v1.y * w1.y) + (v1.z * w1.z + v1.w * w1.w); }
            }
#pragma unroll
            for (int c = 0; c < 8; ++c) g[c] = wave_sum(g[c]);
            if (F.lane < 8) { float s = g[0];
#pragma unroll
                for (int c = 1; c < 8; ++c) s = (F.lane == c) ? g[c] : s;
                gates[(size_t)row * 8 + F.lane] = s + args.in[I_BIN][3072 + F.lane]; }
        }
        __syncthreads();
    }
}

__device__ __forceinline__ void gate_scan(Frame& F, int bh) {
    unsigned char* ws = F.ws;
    const int b = bh >> 2, h = bh & 3, tid = F.tid, lane = F.lane;
    const float* gates = (const float*)(ws + WS_SMALL + SM_GATES);
    LAS float* sA = (LAS float*)F.lds; LAS float* sB = sA + 32; LAS float* sMC = sA + 64; LAS float* sML = sA + 96;
    float ig[8], bb[8], aa[8];
    float run = 0.f;
#pragma unroll
    for (int i = 0; i < 8; ++i) { const size_t t = (size_t)b * SEQ + tid * 8 + i; ig[i] = gates[t * 8 + h]; const float fg = gates[t * 8 + 4 + h];
        const float lf = fminf(fg, 0.f) - log1pf(expf(-fabsf(fg))); run += lf; bb[i] = run; }
    const float tot = run; float v = tot;
#pragma unroll
    for (int off = 1; off < 16; off <<= 1) { const float n = __shfl_up(v, off, 16); if ((lane & 15) >= off) v += n; }
    const float excl = v - tot;
    float amax = -INFINITY;
#pragma unroll
    for (int i = 0; i < 8; ++i) { bb[i] += excl; aa[i] = ig[i] - bb[i]; amax = fmaxf(amax, aa[i]); }
    float gmax = amax;
#pragma unroll
    for (int off = 1; off < 16; off <<= 1) gmax = fmaxf(gmax, __shfl_xor(gmax, off, 16));
    const float blast = __shfl(bb[7], 15, 16);
    const int chunk = tid >> 4;
    if ((tid & 15) == 0) { sA[chunk] = gmax; sB[chunk] = blast; }
    __syncthreads();
    if (tid == 0) { float m = 0.f; for (int c = 0; c < NCHUNK; ++c) { sMC[c] = m; const float Ml = fmaxf(m, sA[c]); sML[c] = Ml; m = sB[c] + Ml; } }
    __syncthreads();
    const float mc = sMC[chunk];
    float pm = amax;
#pragma unroll
    for (int off = 1; off < 16; off <<= 1) { const float n = __shfl_up(pm, off, 16); if ((lane & 15) >= off) pm = fmaxf(pm, n); }
    float ex = __shfl_up(pm, 1, 16); if ((lane & 15) == 0) ex = -INFINITY;
    float cm = fmaxf(mc, ex);
    float* AT = (float*)(ws + WS_SMALL + SM_AT) + (size_t)bh * SEQ + tid * 8; float* MRp = (float*)(ws + WS_SMALL + SM_MR) + (size_t)bh * SEQ + tid * 8; float* EMp = (float*)(ws + WS_SMALL + SM_EM) + (size_t)bh * SEQ + tid * 8;
#pragma unroll
    for (int i = 0; i < 8; ++i) { cm = fmaxf(cm, aa[i]); AT[i] = aa[i]; MRp[i] = cm; EMp[i] = expf(-(bb[i] + cm)); }
    if (tid < NCHUNK) { ((float*)(ws + WS_SMALL + SM_MC))[bh * NCHUNK + tid] = sMC[tid]; ((float*)(ws + WS_SMALL + SM_ML))[bh * NCHUNK + tid] = sML[tid];
        ((float*)(ws + WS_SMALL + SM_DEC))[bh * NCHUNK + tid] = expf(sMC[tid] - sML[tid]); }
    __syncthreads();
}

__device__ __forceinline__ bf16x8 tr_frag(const LAS unsigned char* base, int stride, int row0, int col0, int lane) {
    const int g = lane >> 4, q = (lane & 15) >> 2, p = lane & 3;
    const LAS unsigned char* a = base + (row0 + 8 * g + q) * stride + (col0 + 4 * p) * 2;
    const s16x4 lo = __builtin_amdgcn_ds_read_tr16_b64_v4i16((LAS s16x4*)a);
    const s16x4 hi = __builtin_amdgcn_ds_read_tr16_b64_v4i16((LAS s16x4*)(a + 4 * stride));
    bf16x8 r; r[0] = lo[0]; r[1] = lo[1]; r[2] = lo[2]; r[3] = lo[3]; r[4] = hi[0]; r[5] = hi[1]; r[6] = hi[2]; r[7] = hi[3]; return r;
}
__device__ __forceinline__ bf16x8 row_frag(const LAS unsigned char* base, int stride, int row0, int col0, int lane) {
    return *(const LAS bf16x8*)(base + (row0 + (lane & 15)) * stride + (col0 + 8 * (lane >> 4)) * 2);
}
constexpr int QK_STRIDE = 272;
constexpr int V_STRIDE = 560;
constexpr int MS_QS = 0, MS_KS = 34816, MS_XS = 69632, MS_SMALL = MS_XS + 73984;
static_assert(MS_SMALL + 1536 <= LDS_USABLE, "mLSTM LDS map");

__device__ __forceinline__ void stage_conv_tile(Frame& F, const Args& args, LAS unsigned char* dst, int zcol0, size_t t0, bool first, float scale) {
    const bf16_t* Z = (const bf16_t*)(F.ws + WS_Z);
    const int ch = F.tid & 15, r0 = F.tid >> 4;
    const float* cw = args.in[I_CONVW] + zcol0 + ch * 8; const float* cb = args.in[I_CONVB] + zcol0 + ch * 8;
    float w[4][8], bias[8];
#pragma unroll
    for (int tap = 0; tap < 4; ++tap) { const f32x4 a = *(const f32x4*)(cw + tap * 1024), b = *(const f32x4*)(cw + tap * 1024 + 4);
        w[tap][0] = a.x; w[tap][1] = a.y; w[tap][2] = a.z; w[tap][3] = a.w; w[tap][4] = b.x; w[tap][5] = b.y; w[tap][6] = b.z; w[tap][7] = b.w; }
    { const f32x4 a = *(const f32x4*)cb, b = *(const f32x4*)(cb + 4); bias[0] = a.x; bias[1] = a.y; bias[2] = a.z; bias[3] = a.w; bias[4] = b.x; bias[5] = b.y; bias[6] = b.z; bias[7] = b.w; }
#pragma unroll
    for (int i = 0; i < 4; ++i) {
        const int l = r0 + 32 * i;
        float o[8];
#pragma unroll
        for (int j = 0; j < 8; ++j) o[j] = bias[j];
#pragma unroll
        for (int tap = 0; tap < 4; ++tap) {
            const int lr = l - 3 + tap;
            u32x4 u = (u32x4){0u, 0u, 0u, 0u};
            if (!first || lr >= 0) u = *(const GAS u32x4*)(Z + tb_off((size_t)((long)t0 + lr), zcol0 + ch * 8, ZT));
            o[0] += w[tap][0] * bf_lo(u.x); o[1] += w[tap][1] * bf_hi(u.x); o[2] += w[tap][2] * bf_lo(u.y); o[3] += w[tap][3] * bf_hi(u.y);
            o[4] += w[tap][4] * bf_lo(u.z); o[5] += w[tap][5] * bf_hi(u.z); o[6] += w[tap][6] * bf_lo(u.w); o[7] += w[tap][7] * bf_hi(u.w);
        }
#pragma unroll
        for (int j = 0; j < 8; ++j) o[j] = o[j] * sigmoidf_(o[j]) * scale;
        u32x4 pk; pk.x = cvt_pk_bf16(o[0], o[1]); pk.y = cvt_pk_bf16(o[2], o[3]); pk.z = cvt_pk_bf16(o[4], o[5]); pk.w = cvt_pk_bf16(o[6], o[7]);
        *(LAS u32x4*)(dst + l * QK_STRIDE + ch * 16) = pk;
    }
}
__device__ __forceinline__ void stage_v_tile(Frame& F, LAS unsigned char* dst, int zcol0, size_t t0, const LAS float* wl) {
    const bf16_t* Z = (const bf16_t*)(F.ws + WS_Z);
    const int ch = F.tid & 31, r0 = F.tid >> 5;
#pragma unroll
    for (int i = 0; i < 8; ++i) {
        const int l = r0 + 16 * i;
        const u32x4 u = *(const GAS u32x4*)(Z + tb_off(t0 + l, zcol0 + ch * 8, ZT));
        u32x4 pk = u;
        if (wl) { const float w = wl[l];
            pk.x = cvt_pk_bf16(w * bf_lo(u.x), w * bf_hi(u.x)); pk.y = cvt_pk_bf16(w * bf_lo(u.y), w * bf_hi(u.y)); pk.z = cvt_pk_bf16(w * bf_lo(u.z), w * bf_hi(u.z)); pk.w = cvt_pk_bf16(w * bf_lo(u.w), w * bf_hi(u.w)); }
        *(LAS u32x4*)(dst + l * V_STRIDE + ch * 16) = pk;
    }
    if (F.tid < 128) { const float w = wl ? wl[F.tid] : 1.0f; u32x4 a = (u32x4){cvt_pk_bf16(w, 0.f), 0u, 0u, 0u}; const u32x4 z = (u32x4){0u, 0u, 0u, 0u};
        *(LAS u32x4*)(dst + F.tid * V_STRIDE + 512) = a; *(LAS u32x4*)(dst + F.tid * V_STRIDE + 528) = z; }
}

__device__ __forceinline__ void mlstm_m1_unit(Frame& F, const Args& args, int bh, int c) {
    const int b = bh >> 2, h = bh & 3, lane = F.lane, w = F.wave;
    const size_t t0 = (size_t)b * SEQ + c * CHUNK;
    LAS unsigned char* KS = F.lds + MS_KS; LAS unsigned char* XS = F.lds + MS_XS; LAS float* wl = (LAS float*)(F.lds + MS_SMALL);
    if (F.tid < 128) { const float a = ((const float*)(F.ws + WS_SMALL + SM_AT))[(size_t)bh * SEQ + c * CHUNK + F.tid]; const float Ml = ((const float*)(F.ws + WS_SMALL + SM_ML))[bh * NCHUNK + c]; wl[F.tid] = expf(a - Ml); }
    stage_conv_tile(F, args, KS, ZC_QK + M_QK + h * M_QK_DIM, t0, c == 0, 0.08838834764831845f);
    __syncthreads();
    stage_v_tile(F, XS, ZC_V + h * M_V_DIM, t0, wl);
    __syncthreads();
    f32x4 acc[17];
#pragma unroll
    for (int i = 0; i < 17; ++i) acc[i] = (f32x4){0.f, 0.f, 0.f, 0.f};
#pragma unroll
    for (int ks = 0; ks < 4; ++ks) {
        const bf16x8 kf = tr_frag(KS, QK_STRIDE, 32 * ks, 16 * w, lane);
#pragma unroll
        for (int cv = 0; cv < 17; ++cv) { const bf16x8 vf = tr_frag(XS, V_STRIDE, 32 * ks, 16 * cv, lane); acc[cv] = __builtin_amdgcn_mfma_f32_16x16x32_bf16(kf, vf, acc[cv], 0, 0, 0); }
    }
    bf16_t* dkv = (bf16_t*)(F.ws + S2_DKV) + (size_t)(bh * NCHUNK + c) * 272 * 128;
    { const int q4 = lane >> 4, odd = q4 & 1;
#pragma unroll
      for (int p = 0; p < 8; ++p) {
          const f32x4 snd = odd ? acc[2 * p] : acc[2 * p + 1], own = odd ? acc[2 * p + 1] : acc[2 * p];
          f32x4 rx; rx.x = __shfl_xor(snd.x, 16); rx.y = __shfl_xor(snd.y, 16); rx.z = __shfl_xor(snd.z, 16); rx.w = __shfl_xor(snd.w, 16);
          const f32x4 lo = odd ? rx : own, hi = odd ? own : rx;
          const int v = 32 * p + 16 * odd + (lane & 15), d0 = 16 * w + 4 * (q4 & 2);
          *(GAS u32x4*)(dkv + (size_t)v * 128 + d0) = pack8(lo, hi); }
      if ((lane & 15) == 0) { u32x2 o; o.x = cvt_pk_bf16(acc[16].x, acc[16].y); o.y = cvt_pk_bf16(acc[16].z, acc[16].w); *(GAS u32x2*)(dkv + (size_t)256 * 128 + 16 * w + 4 * q4) = o; } }
    __syncthreads();
}

__device__ __forceinline__ void mlstm_m2(Frame& F) {
    const int gt = F.vcu * NTHREADS + F.tid, NGT = F.G * NTHREADS;
    constexpr int Q8 = 257 * 128 / 8, CS8 = 272 * 128 / 8;
    const float* dec = (const float*)(F.ws + WS_SMALL + SM_DEC);
    for (int it = gt; it < NBH * Q8; it += NGT) {
        const int bh = it / Q8, q = it % Q8;
        const u32x4* src = (const u32x4*)(F.ws + S2_DKV) + (size_t)bh * NCHUNK * CS8 + q;
        u32x4* dst = (u32x4*)(F.ws + S2_CST) + (size_t)bh * NCHUNK * CS8 + q;
        f32x4 C0 = (f32x4){0.f, 0.f, 0.f, 0.f}, C1 = C0;
#pragma unroll 8
        for (int c = 0; c < NCHUNK; ++c) {
            const u32x4 d = src[(size_t)c * CS8]; const float dc = dec[bh * NCHUNK + c];
            dst[(size_t)c * CS8] = pack8(C0, C1);
            C0 = C0 * dc + unpk_lo(d); C1 = C1 * dc + unpk_hi(d);
        }
    }
}

__device__ __forceinline__ void mlstm_m3_unit(Frame& F, const Args& args, int bh, int c) {
    const int b = bh >> 2, h = bh & 3, lane = F.lane, w = F.wave, tid = F.tid;
    const size_t t0 = (size_t)b * SEQ + c * CHUNK;
    LAS unsigned char* QS = F.lds + MS_QS; LAS unsigned char* KS = F.lds + MS_KS; LAS unsigned char* XS = F.lds + MS_XS;
    LAS float* sa = (LAS float*)(F.lds + MS_SMALL); LAS float* smr = sa + 128; LAS float* sem = sa + 256;
    if (tid < 128) { const size_t o = (size_t)bh * SEQ + c * CHUNK + tid;
        sa[tid] = ((const float*)(F.ws + WS_SMALL + SM_AT))[o]; smr[tid] = ((const float*)(F.ws + WS_SMALL + SM_MR))[o]; sem[tid] = ((const float*)(F.ws + WS_SMALL + SM_EM))[o]; }
    const float mc = ((const float*)(F.ws + WS_SMALL + SM_MC))[bh * NCHUNK + c];
    stage_conv_tile(F, args, QS, ZC_QK + h * M_QK_DIM, t0, c == 0, 1.0f);
    asm volatile("" ::: "memory");
    stage_conv_tile(F, args, KS, ZC_QK + M_QK + h * M_QK_DIM, t0, c == 0, 0.08838834764831845f);
    asm volatile("" ::: "memory");
    { const u32x4* cst = (const u32x4*)(F.ws + S2_CST) + (size_t)(bh * NCHUNK + c) * (272 * 128 / 8);
      u32x4 cv_[9];
#pragma unroll
      for (int k = 0; k < 9; ++k) { const int it = tid + k * NTHREADS, r = it >> 4; cv_[k] = (u32x4){0u, 0u, 0u, 0u}; if (it < 272 * 16 && r <= 256) cv_[k] = cst[it]; }
#pragma unroll
      for (int k = 0; k < 9; ++k) { const int it = tid + k * NTHREADS, r = it >> 4, ch = it & 15; if (it < 272 * 16) *(LAS u32x4*)(XS + r * QK_STRIDE + ch * 16) = cv_[k]; } }
    __syncthreads();
    const int j = 16 * w + (lane & 15);
    const float mrj = smr[j], emj = sem[j], spj = expf(mc - mrj);
    bf16x8 qf[4];
#pragma unroll
    for (int ks = 0; ks < 4; ++ks) qf[ks] = row_frag(QS, QK_STRIDE, 16 * w, 32 * ks, lane);
    f32x4 st[8];
#pragma unroll
    for (int lt = 0; lt < 8; ++lt) { st[lt] = (f32x4){0.f, 0.f, 0.f, 0.f};
        if (lt <= w) {
#pragma unroll
            for (int ks = 0; ks < 4; ++ks) { const bf16x8 kf = row_frag(KS, QK_STRIDE, 16 * lt, 32 * ks, lane); st[lt] = __builtin_amdgcn_mfma_f32_16x16x32_bf16(kf, qf[ks], st[lt], 0, 0, 0); } } }
    f32x4 acc[17];
#pragma unroll
    for (int cv = 0; cv < 17; ++cv) { acc[cv] = (f32x4){0.f, 0.f, 0.f, 0.f};
#pragma unroll
        for (int ks = 0; ks < 4; ++ks) { const bf16x8 cf = row_frag(XS, QK_STRIDE, 16 * cv, 32 * ks, lane); acc[cv] = __builtin_amdgcn_mfma_f32_16x16x32_bf16(cf, qf[ks], acc[cv], 0, 0, 0); }
        acc[cv] = acc[cv] * spj; }
    __syncthreads();
#pragma unroll
    for (int lt = 0; lt < 8; ++lt) {
        const int l0 = 16 * lt + 4 * (lane >> 4);
        u32x2 pk = (u32x2){0u, 0u};
        if (lt <= w) { float e[4];
#pragma unroll
            for (int r = 0; r < 4; ++r) { const float f = expf(sa[l0 + r] - mrj); e[r] = (lt < w || (l0 + r) <= j) ? st[lt][r] * f : 0.f; }
            pk.x = cvt_pk_bf16(e[0], e[1]); pk.y = cvt_pk_bf16(e[2], e[3]); }
        *(LAS u32x2*)(KS + j * QK_STRIDE + l0 * 2) = pk;
    }
    stage_v_tile(F, XS, ZC_V + h * M_V_DIM, t0, nullptr);
    __syncthreads();
#pragma unroll
    for (int ks = 0; ks < 4; ++ks) {
        if (ks <= (w >> 1)) { const bf16x8 sf = row_frag(KS, QK_STRIDE, 16 * w, 32 * ks, lane);
#pragma unroll
            for (int cv = 0; cv < 17; ++cv) { const bf16x8 vf = tr_frag(XS, V_STRIDE, 32 * ks, 16 * cv, lane); acc[cv] = __builtin_amdgcn_mfma_f32_16x16x32_bf16(vf, sf, acc[cv], 0, 0, 0); } } }
    const float den = __shfl(acc[16].x, lane & 15);
    const float inv = 1.0f / fmaxf(fabsf(den), emj);
    float s = 0.f;
#pragma unroll
    for (int cv = 0; cv < 16; ++cv) { acc[cv] = acc[cv] * inv; s += (acc[cv].x + acc[cv].y) + (acc[cv].z + acc[cv].w); }
    s += __shfl_xor(s, 16); s += __shfl_xor(s, 32);
    const float mu = s * (1.0f / 256.0f);
    float q = 0.f;
#pragma unroll
    for (int cv = 0; cv < 16; ++cv) { const f32x4 d = acc[cv] - mu; q += (d.x * d.x + d.y * d.y) + (d.z * d.z + d.w * d.w); }
    q += __shfl_xor(q, 16); q += __shfl_xor(q, 32);
    const float rstd = 1.0f / sqrtf(q * (1.0f / 256.0f) + LN_EPS);
    const bf16_t* Z = (const bf16_t*)(F.ws + WS_Z); bf16_t* HG = (bf16_t*)(F.outb + OUT_HG);
    const size_t t = t0 + j;
    const bf16_t* Zo = Z + tb_off(t, ZC_O + h * M_V_DIM, ZT) + 4 * (lane >> 4);
#pragma unroll
    for (int cv = 0; cv < 16; ++cv) { const int v = h * M_V_DIM + 16 * cv + 4 * (lane >> 4);
        const f32x4 g = *(const f32x4*)(args.in[I_MHG] + v); const u32x2 so = *(const GAS u32x2*)(Zo + 16 * cv);
        const f32x4 d = (acc[cv] - mu) * rstd;
        u32x2 o; o.x = cvt_pk_bf16(d.x * g.x * bf_lo(so.x), d.y * g.y * bf_hi(so.x)); o.y = cvt_pk_bf16(d.z * g.z * bf_lo(so.y), d.w * g.w * bf_hi(so.y));
        *(GAS u32x2*)((unsigned char*)HG + ta_off(t, v, 16)) = o; }
    __syncthreads();
}

template <int WIN>
__device__ __forceinline__ void pool_item(const bf16_t* Z, bf16_t* PU, size_t t0, int tb0, int col) {
    u32x4 u[15 + WIN];
#pragma unroll
    for (int k = 0; k < 15 + WIN; ++k) { const int rel = k - (WIN - 1); u[k] = (u32x4){0u, 0u, 0u, 0u}; if (tb0 + rel >= 0) u[k] = *(const GAS u32x4*)(Z + tb_off((size_t)((long)t0 + rel), ZC_U + col, ZT)); }
    float sum[8];
#pragma unroll
    for (int j = 0; j < 8; ++j) sum[j] = 0.f;
#pragma unroll
    for (int k = 0; k < WIN - 1; ++k) { sum[0] += bf_lo(u[k].x); sum[1] += bf_hi(u[k].x); sum[2] += bf_lo(u[k].y); sum[3] += bf_hi(u[k].y); sum[4] += bf_lo(u[k].z); sum[5] += bf_hi(u[k].z); sum[6] += bf_lo(u[k].w); sum[7] += bf_hi(u[k].w); }
#pragma unroll
    for (int r = 0; r < 16; ++r) {
        const u32x4 c = u[r + WIN - 1]; const int tb = tb0 + r;
        const float cur[8] = {bf_lo(c.x), bf_hi(c.x), bf_lo(c.y), bf_hi(c.y), bf_lo(c.z), bf_hi(c.z), bf_lo(c.w), bf_hi(c.w)};
        const float rc = 1.0f / (float)((tb + 1) < WIN ? (tb + 1) : WIN);
        float o[8];
#pragma unroll
        for (int j = 0; j < 8; ++j) { sum[j] += cur[j]; o[j] = sum[j] * rc - cur[j]; }
        u32x4 pk; pk.x = cvt_pk_bf16(o[0], o[1]); pk.y = cvt_pk_bf16(o[2], o[3]); pk.z = cvt_pk_bf16(o[4], o[5]); pk.w = cvt_pk_bf16(o[6], o[7]);
        *(GAS u32x4*)((unsigned char*)PU + ta_off(t0 + r, col, 16)) = pk;
        const u32x4 v = u[r];
        sum[0] -= bf_lo(v.x); sum[1] -= bf_hi(v.x); sum[2] -= bf_lo(v.y); sum[3] -= bf_hi(v.y); sum[4] -= bf_lo(v.z); sum[5] -= bf_hi(v.z); sum[6] -= bf_lo(v.w); sum[7] -= bf_hi(v.w);
    }
}
__device__ __forceinline__ void pool_phase(Frame& F) {
    const int gw = F.vcu * NWAVES + F.wave, NGW = F.G * NWAVES;
    const bf16_t* Z = (const bf16_t*)(F.ws + WS_Z); bf16_t* PU = (bf16_t*)(F.outb + OUT_PU);
    for (int wi = gw; wi < (T_TOK / 32) * 4; wi += NGW) {
        const int g = wi & 3, run = (wi >> 2) * 2 + (F.lane >> 5), col = g * 256 + (F.lane & 31) * 8;
        const size_t t0 = (size_t)run * 16; const int tb0 = (int)(t0 & (SEQ - 1));
        if (g == 0) pool_item<2>(Z, PU, t0, tb0, col); else if (g == 1) pool_item<4>(Z, PU, t0, tb0, col); else if (g == 2) pool_item<8>(Z, PU, t0, tb0, col); else pool_item<16>(Z, PU, t0, tb0, col);
    }
}

constexpr int RT_XSTRIDE = 4112;
constexpr int RT_XL = 16 * RT_XSTRIDE, RT_LG = 32768;
static_assert(2 * RT_XL <= LDS_USABLE, "router LDS map");
__device__ __forceinline__ void ln1_router_phase(Frame& F, const Args& args) {
    const int lane = F.lane, w = F.wave, tid = F.tid;
    const bf16_t* HB = (const bf16_t*)(F.ws + Z_X1); const bf16_t* xin = (const bf16_t*)(F.outb + OUT_XB); bf16_t* X1B = (bf16_t*)(F.ws + S2_X1B); unsigned char* X1F8 = F.ws + S2_X1F8;
    const bf16_t* WRh = (const bf16_t*)(F.ws + W_RT); const bf16_t* WRl = WRh + 48 * 2048;
    unsigned* cnt = (unsigned*)(F.ws + WS_CTL) + CW_CNT; int* TL = (int*)(F.ws + WS_SMALL + SM_TL); float* GWp = (float*)(F.ws + WS_SMALL + SM_GW);
    LAS unsigned char* XH = F.lds; LAS unsigned char* XL = F.lds + RT_XL; LAS f32x4* red = (LAS f32x4*)F.lds; LAS float* lg = (LAS float*)(F.lds + RT_LG);
    u32x4 xq[2][4], hq[2][4];
#define LN1_LOAD(G_) do { _Pragma("unroll") for (int rr = 0; rr < 2; ++rr) { const size_t row_ = (size_t)(G_) * 16 + 2 * w + rr; _Pragma("unroll") for (int i = 0; i < 4; ++i) { const int e0 = i * 512 + lane * 8; \
        xq[rr][i] = *(const GAS u32x4*)(xin + row_ * 2048 + e0); hq[rr][i] = *(const GAS u32x4*)(HB + tb_off(row_, e0, 8)); } } } while (0)
    if (F.vcu < T_TOK / 16) LN1_LOAD(F.vcu);
    for (int grp = F.vcu; grp < T_TOK / 16; grp += F.G) {
        float v[2][32];
#pragma unroll
        for (int rr = 0; rr < 2; ++rr)
#pragma unroll
            for (int i = 0; i < 4; ++i) { const u32x4 xx = xq[rr][i]; const f32x4 a = (f32x4){bf_lo(xx.x), bf_hi(xx.x), bf_lo(xx.y), bf_hi(xx.y)}, b = (f32x4){bf_lo(xx.z), bf_hi(xx.z), bf_lo(xx.w), bf_hi(xx.w)}; const u32x4 hh = hq[rr][i];
                v[rr][8 * i + 0] = ALPHA * a.x + bf_lo(hh.x); v[rr][8 * i + 1] = ALPHA * a.y + bf_hi(hh.x); v[rr][8 * i + 2] = ALPHA * a.z + bf_lo(hh.y); v[rr][8 * i + 3] = ALPHA * a.w + bf_hi(hh.y);
                v[rr][8 * i + 4] = ALPHA * b.x + bf_lo(hh.z); v[rr][8 * i + 5] = ALPHA * b.y + bf_hi(hh.z); v[rr][8 * i + 6] = ALPHA * b.z + bf_lo(hh.w); v[rr][8 * i + 7] = ALPHA * b.w + bf_hi(hh.w); }
#pragma unroll
        for (int rr = 0; rr < 2; ++rr) {
            const int lr = 2 * w + rr; const size_t row = (size_t)grp * 16 + lr;
            float s = 0.f;
#pragma unroll
            for (int i = 0; i < 32; ++i) s += v[rr][i];
            const float mean = wave_sum(s) * (1.0f / 2048.0f); float q = 0.f;
#pragma unroll
            for (int i = 0; i < 32; ++i) { v[rr][i] -= mean; q += v[rr][i] * v[rr][i]; }
            const float rstd = 1.0f / sqrtf(wave_sum(q) * (1.0f / 2048.0f) + LN_EPS);
#pragma unroll
            for (int i = 0; i < 4; ++i) { const int e0 = i * 512 + lane * 8; float y[8];
                { const f32x4 g0 = *(const f32x4*)(args.in[I_LN1G] + e0), g1 = *(const f32x4*)(args.in[I_LN1G] + e0 + 4), b0 = *(const f32x4*)(args.in[I_LN1B] + e0), b1 = *(const f32x4*)(args.in[I_LN1B] + e0 + 4);
                  y[0] = v[rr][8 * i + 0] * rstd * g0.x + b0.x; y[1] = v[rr][8 * i + 1] * rstd * g0.y + b0.y; y[2] = v[rr][8 * i + 2] * rstd * g0.z + b0.z; y[3] = v[rr][8 * i + 3] * rstd * g0.w + b0.w;
                  y[4] = v[rr][8 * i + 4] * rstd * g1.x + b1.x; y[5] = v[rr][8 * i + 5] * rstd * g1.y + b1.y; y[6] = v[rr][8 * i + 6] * rstd * g1.z + b1.z; y[7] = v[rr][8 * i + 7] * rstd * g1.w + b1.w; }
                u32x4 hi; hi.x = cvt_pk_bf16(y[0], y[1]); hi.y = cvt_pk_bf16(y[2], y[3]); hi.z = cvt_pk_bf16(y[4], y[5]); hi.w = cvt_pk_bf16(y[6], y[7]);
                *(GAS u32x4*)(X1B + row * 2048 + e0) = hi;
                { u32x2 f8; f8.x = pk4_fp8(y[0] * A8_SCALE, y[1] * A8_SCALE, y[2] * A8_SCALE, y[3] * A8_SCALE); f8.y = pk4_fp8(y[4] * A8_SCALE, y[5] * A8_SCALE, y[6] * A8_SCALE, y[7] * A8_SCALE); *(GAS u32x2*)(X1F8 + row * 2048 + e0) = f8; }
                u32x4 lo; lo.x = cvt_pk_bf16(y[0] - bf_lo(hi.x), y[1] - bf_hi(hi.x)); lo.y = cvt_pk_bf16(y[2] - bf_lo(hi.y), y[3] - bf_hi(hi.y)); lo.z = cvt_pk_bf16(y[4] - bf_lo(hi.z), y[5] - bf_hi(hi.z)); lo.w = cvt_pk_bf16(y[6] - bf_lo(hi.w), y[7] - bf_hi(hi.w));
                *(LAS u32x4*)(XH + lr * RT_XSTRIDE + e0 * 2) = hi; *(LAS u32x4*)(XL + lr * RT_XSTRIDE + e0 * 2) = lo; }
        }
        __syncthreads();
        if (grp + F.G < T_TOK / 16) LN1_LOAD(grp + F.G);
        f32x4 acc[3];
#pragma unroll
        for (int t = 0; t < 3; ++t) acc[t] = (f32x4){0.f, 0.f, 0.f, 0.f};
#pragma unroll 2
        for (int s8 = 0; s8 < 8; ++s8) {
            const int kk = 256 * w + 32 * s8 + 8 * (lane >> 4);
            const bf16x8 ah = *(const LAS bf16x8*)(XH + (lane & 15) * RT_XSTRIDE + kk * 2), al = *(const LAS bf16x8*)(XL + (lane & 15) * RT_XSTRIDE + kk * 2);
#pragma unroll
            for (int t = 0; t < 3; ++t) { const size_t o = (size_t)(16 * t + (lane & 15)) * 2048 + kk;
                const bf16x8 bh = *(const GAS bf16x8*)(WRh + o), bl = *(const GAS bf16x8*)(WRl + o);
                acc[t] = __builtin_amdgcn_mfma_f32_16x16x32_bf16(ah, bh, acc[t], 0, 0, 0); acc[t] = __builtin_amdgcn_mfma_f32_16x16x32_bf16(al, bh, acc[t], 0, 0, 0); acc[t] = __builtin_amdgcn_mfma_f32_16x16x32_bf16(ah, bl, acc[t], 0, 0, 0); }
        }
        __syncthreads();
#pragma unroll
        for (int t = 0; t < 3; ++t) red[(w * 3 + t) * 64 + lane] = acc[t];
        __syncthreads();
        for (int idx = tid; idx < 16 * 36; idx += NTHREADS) { const int row = idx / 36, n = idx % 36, t = n >> 4, sl = (row >> 2) * 16 + (n & 15), rg = row & 3;
            float s = 0.f;
#pragma unroll
            for (int ww = 0; ww < 8; ++ww) s += ((const LAS float*)&red[(ww * 3 + t) * 64 + sl])[rg];
            lg[row * 48 + n] = s + (n < 4 ? args.in[I_BRG][n] : args.in[I_BRE][n - 4]); }
        __syncthreads();
        if (tid < 16) {
            const LAS float* L = lg + tid * 48; const int tok = grp * 16 + tid;
            int gi = 0; float gm = L[0];
#pragma unroll
            for (int i = 1; i < 4; ++i) if (L[i] > gm) { gm = L[i]; gi = i; }
            float gs = 0.f;
#pragma unroll
            for (int i = 0; i < 4; ++i) gs += expf(L[i] - gm);
            const float pg = 1.0f / gs;
            const LAS float* E = L + 4 + gi * 8;
            int e1 = 0; float l1 = E[0];
#pragma unroll
            for (int i = 1; i < 8; ++i) if (E[i] > l1) { l1 = E[i]; e1 = i; }
            int e2 = -1; float l2 = -INFINITY;
#pragma unroll
            for (int i = 0; i < 8; ++i) if (i != e1 && E[i] > l2) { l2 = E[i]; e2 = i; }
            const float r = expf(l2 - l1), g1 = pg / (1.0f + r), g2 = pg * r / (1.0f + r);
            const int ea = gi * 8 + e1, eb = gi * 8 + e2;
            const unsigned pa = atomicAdd(cnt + 64 * ea, 1u); TL[(size_t)ea * TL_CAP + pa] = tok * 2; GWp[tok * 2] = g1;
            const unsigned pb = atomicAdd(cnt + 64 * eb, 1u); TL[(size_t)eb * TL_CAP + pb] = tok * 2 + 1; GWp[tok * 2 + 1] = g2;
        }
        __syncthreads();
    }
}

__device__ __forceinline__ void ln2_phase(Frame& F, const Args& args) {
    const int lane = F.lane, gw = F.vcu * NWAVES + F.wave, NGW = F.G * NWAVES;
    const bf16_t* Y = (const bf16_t*)(F.ws + Z_Y); const bf16_t* XB = (const bf16_t*)(F.ws + S2_X1B); bf16_t* XO = (bf16_t*)(F.ws + S2_X2B); unsigned char* X2F8 = F.ws + Z_X2F8;
    for (int rp = gw; rp < T_TOK / 2; rp += NGW) {
        float v[2][32];
#pragma unroll
        for (int rr = 0; rr < 2; ++rr) { const size_t row = (size_t)rp * 2 + rr;
#pragma unroll
            for (int i = 0; i < 4; ++i) { const int e0 = i * 512 + lane * 8;
                const u32x4 a = *(const GAS u32x4*)(XB + row * 2048 + e0);
                const u32x4 y0 = *(const GAS u32x4*)(Y + (2 * row) * 2048 + e0), y1 = *(const GAS u32x4*)(Y + (2 * row + 1) * 2048 + e0);
                v[rr][8 * i + 0] = ALPHA * bf_lo(a.x) + bf_lo(y0.x) + bf_lo(y1.x); v[rr][8 * i + 1] = ALPHA * bf_hi(a.x) + bf_hi(y0.x) + bf_hi(y1.x); v[rr][8 * i + 2] = ALPHA * bf_lo(a.y) + bf_lo(y0.y) + bf_lo(y1.y); v[rr][8 * i + 3] = ALPHA * bf_hi(a.y) + bf_hi(y0.y) + bf_hi(y1.y);
                v[rr][8 * i + 4] = ALPHA * bf_lo(a.z) + bf_lo(y0.z) + bf_lo(y1.z); v[rr][8 * i + 5] = ALPHA * bf_hi(a.z) + bf_hi(y0.z) + bf_hi(y1.z); v[rr][8 * i + 6] = ALPHA * bf_lo(a.w) + bf_lo(y0.w) + bf_lo(y1.w); v[rr][8 * i + 7] = ALPHA * bf_hi(a.w) + bf_hi(y0.w) + bf_hi(y1.w); } }
#pragma unroll
        for (int rr = 0; rr < 2; ++rr) { const size_t row = (size_t)rp * 2 + rr;
            float s = 0.f;
#pragma unroll
            for (int i = 0; i < 32; ++i) s += v[rr][i];
            const float mean = wave_sum(s) * (1.0f / 2048.0f); float q = 0.f;
#pragma unroll
            for (int i = 0; i < 32; ++i) { v[rr][i] -= mean; q += v[rr][i] * v[rr][i]; }
            const float rstd = 1.0f / sqrtf(wave_sum(q) * (1.0f / 2048.0f) + LN_EPS);
#pragma unroll
            for (int i = 0; i < 4; ++i) { const int e0 = i * 512 + lane * 8; float y[8];
                const f32x4 g0 = *(const f32x4*)(args.in[I_LN2G] + e0), g1 = *(const f32x4*)(args.in[I_LN2G] + e0 + 4), b0 = *(const f32x4*)(args.in[I_LN2B] + e0), b1 = *(const f32x4*)(args.in[I_LN2B] + e0 + 4);
                y[0] = v[rr][8 * i + 0] * rstd * g0.x + b0.x; y[1] = v[rr][8 * i + 1] * rstd * g0.y + b0.y; y[2] = v[rr][8 * i + 2] * rstd * g0.z + b0.z; y[3] = v[rr][8 * i + 3] * rstd * g0.w + b0.w;
                y[4] = v[rr][8 * i + 4] * rstd * g1.x + b1.x; y[5] = v[rr][8 * i + 5] * rstd * g1.y + b1.y; y[6] = v[rr][8 * i + 6] * rstd * g1.z + b1.z; y[7] = v[rr][8 * i + 7] * rstd * g1.w + b1.w;
                u32x4 hi; hi.x = cvt_pk_bf16(y[0], y[1]); hi.y = cvt_pk_bf16(y[2], y[3]); hi.z = cvt_pk_bf16(y[4], y[5]); hi.w = cvt_pk_bf16(y[6], y[7]);
                *(GAS u32x4*)(XO + tb_off(row, e0, 8)) = hi;
                u32x2 f8; f8.x = pk4_fp8(y[0] * A8_SCALE, y[1] * A8_SCALE, y[2] * A8_SCALE, y[3] * A8_SCALE); f8.y = pk4_fp8(y[4] * A8_SCALE, y[5] * A8_SCALE, y[6] * A8_SCALE, y[7] * A8_SCALE); *(GAS u32x2*)(X2F8 + row * 2048 + e0) = f8; }
        }
    }
}

struct StaticSched {
    static constexpr bool GATHER = false;
    const char* A0; const char* A1; const char* B0; const char* B1; int lda, ldb, nM, nN, nwg, G, c, nseg;
    __device__ __forceinline__ void init(const void* a0, const void* a1, const void* b0, const void* b1, int lda_, int ldb_, int M, int N, int G_, int c_, int nseg_) {
        A0 = (const char*)a0; A1 = (const char*)a1; B0 = (const char*)b0; B1 = (const char*)b1; lda = lda_; ldb = ldb_; nM = M / 256; nN = N / 256; nwg = nM * nN; G = G_; c = c_; nseg = nseg_; }
    __device__ __forceinline__ bool next(int i, pg8::Unit& u) const {
        const int base = (nseg == 2) ? (i >> 1) : i; const long L = (long)base * G + c; if (L >= nwg) return false;
        const int wgid = pg8::xcd_remap((int)L, nwg); pg8::tile_of(wgid, nM, nN, u.pm, u.pn); u.seg = (nseg == 2) ? (i & 1) : 0; u.aux = 0; return true; }
    __device__ __forceinline__ const char* abase(const pg8::Unit& u) const { return (u.seg ? A1 : A0) + (size_t)u.pm * 256 * lda * 2; }
    __device__ __forceinline__ const char* bbase(const pg8::Unit& u) const { return (u.seg ? B1 : B0) + (size_t)u.pn * (ldb / 64) * 32768; }
    __device__ __forceinline__ void gather(const pg8::Unit&, const int (&)[2], const int (&)[2], unsigned (&)[2][2]) const {}
};
struct ZSched {
    static constexpr bool GATHER = false;
    const char* A; const char* B; int lda, ldb, nN, nwg, G, c; unsigned mask;
    __device__ __forceinline__ void init(const void* a, const void* b, int lda_, int ldb_, unsigned mask_, int G_, int c_) { A = (const char*)a; B = (const char*)b; lda = lda_; ldb = ldb_; mask = mask_; nN = __builtin_popcount(mask_); nwg = 64 * nN; G = G_; c = c_; }
    __device__ __forceinline__ bool next(int i, pg8::Unit& u) const {
        const long L = (long)i * G + c; if (L >= nwg) return false;
        const int wgid = pg8::xcd_remap((int)L, nwg); int pn; pg8::tile_of(wgid, 64, nN, u.pm, pn);
        unsigned m = mask; for (int k = 0; k < pn; ++k) m &= m - 1;
        u.pn = __builtin_ctz(m); u.seg = 0; u.aux = 0; return true; }
    __device__ __forceinline__ const char* abase(const pg8::Unit& u) const { return A + (size_t)u.pm * 256 * lda * 2; }
    __device__ __forceinline__ const char* bbase(const pg8::Unit& u) const { return B + (size_t)u.pn * (ldb / 64) * 32768; }
    __device__ __forceinline__ void gather(const pg8::Unit&, const int (&)[2], const int (&)[2], unsigned (&)[2][2]) const {}
};
constexpr int LDS_TAB_OFF = RING_BYTES;
template <bool GATHER_>
struct MoeSched {
    static constexpr bool GATHER = GATHER_;
    const LAS int* tstart; const LAS int* cntl; const char* Abase; const char* Bbase; const int* TL; size_t estride; int lda, ldb, NT, nwg, G, c;
    __device__ __forceinline__ bool next(int i, pg8::Unit& u) const {
        const long L = (long)i * G + c; if (L >= nwg) return false;
        const int wgid = pg8::xcd_remap((int)L, nwg); const int rt = wgid / NT; u.pn = wgid % NT; int e = 0;
        while (e < N_EXPERTS - 1 && tstart[e + 1] <= rt) ++e;
        u.pm = rt; u.aux = e; u.seg = rt - tstart[e]; return true; }
    __device__ __forceinline__ const char* abase(const pg8::Unit& u) const { return GATHER ? Abase : Abase + (size_t)u.pm * 256 * lda * 2; }
    __device__ __forceinline__ const char* bbase(const pg8::Unit& u) const { return Bbase + (size_t)u.aux * estride + (size_t)u.pn * (ldb / 64) * 32768; }
    __device__ __forceinline__ void gather(const pg8::Unit& u, const int (&R)[2], const int (&C)[2], unsigned (&voff)[2][2]) const {
        const int cn = cntl[u.aux];
#pragma unroll
        for (int h = 0; h < 2; ++h)
#pragma unroll
            for (int i = 0; i < 2; ++i) { const int idx = u.seg * 256 + h * 128 + R[i]; int asg = 0; if (idx < cn) asg = TL[(size_t)u.aux * TL_CAP + idx];
                voff[h][i] = (unsigned)(asg >> 1) * (unsigned)(lda * 2) + (unsigned)C[i] * 2u; } }
};

typedef const f32x4 (&AccRef)[2][2][4][2];
__device__ __forceinline__ size_t gate_off(int pm, int tile, int ai, int m, int wr, int wc, int fr, int fq) { return ((size_t)(pm * 16 + tile) * 8 + (size_t)(ai * 4 + m)) * 8192 + (size_t)(((wr * 4 + wc) * 64 + fq * 16 + fr) * 16); }
__device__ __forceinline__ size_t frag_off(int pm, int tile, int ntile, int ai, int m, int bj, int wr, int wc, int fr, int fq) { return ((size_t)(pm * ntile + tile) * 16 + (size_t)((ai * 4 + m) * 2 + bj)) * 8192 + (size_t)(((wr * 4 + wc) * 64 + fq * 16 + fr) * 16); }
__device__ __forceinline__ f32x4 sig4(const f32x4 v) { return (f32x4){sigmoidf_(v.x), sigmoidf_(v.y), sigmoidf_(v.z), sigmoidf_(v.w)}; }

struct EpiZ {
    static constexpr bool PERM = true; bf16_t* Z; unsigned char* GT; const float* bias; float scale;
    __device__ __forceinline__ void operator()(AccRef acc, const pg8::Unit& u, int wr, int wc, int fr, int fq) const {
        const int row0 = u.pm * 256 + wr * 64 + fr, col0 = u.pn * 256 + wc * 32 + 8 * fq, bcol0 = col0 + (u.pn >= 12 ? 8 : 0);
        const bool sg = (u.pn >= 8 && u.pn < 12) || u.pn >= 16, gt = u.pn >= 16;
        f32x4 bv[2][2];
#pragma unroll
        for (int bj = 0; bj < 2; ++bj)
#pragma unroll
            for (int n = 0; n < 2; ++n) bv[bj][n] = *(const f32x4*)(bias + bcol0 + bj * 128 + 4 * n);
#pragma unroll
        for (int ai = 0; ai < 2; ++ai)
#pragma unroll
            for (int m = 0; m < 4; ++m) {
                f32x4 v00 = acc[ai][0][m][0] * scale + bv[0][0], v01 = acc[ai][0][m][1] * scale + bv[0][1], v10 = acc[ai][1][m][0] * scale + bv[1][0], v11 = acc[ai][1][m][1] * scale + bv[1][1];
                if (sg) { v00 = sig4(v00); v01 = sig4(v01); v10 = sig4(v10); v11 = sig4(v11); }
                if (gt) { u32x4 q; q.x = pk4_u8(v00); q.y = pk4_u8(v01); q.z = pk4_u8(v10); q.w = pk4_u8(v11); *(GAS u32x4*)(GT + gate_off(u.pm, u.pn - 16, ai, m, wr, wc, fr, fq)) = q; }
                else { bf16_t* rowp = Z + tb_off((size_t)(row0 + ai * 128 + m * 16), col0 & 4095, ZT); *(GAS u32x4*)rowp = pack8(v00, v01); *(GAS u32x4*)(rowp + 128) = pack8(v10, v11); } }
    }
};
struct EpiMerge {
    static constexpr bool PERM = true; const unsigned char* GT; unsigned char* park; bf16_t* merged;
    __device__ __forceinline__ void operator()(AccRef acc, const pg8::Unit& u, int wr, int wc, int fr, int fq) const {
        const int row0 = u.pm * 256 + wr * 64 + fr, col0 = u.pn * 256 + wc * 32 + 8 * fq; const int gtile = u.seg ? u.pn : 8 + u.pn;
#pragma unroll
        for (int ai = 0; ai < 2; ++ai) {
            u32x4 gq[4], pk[4][2];
#pragma unroll
            for (int m = 0; m < 4; ++m)
#pragma unroll
                for (int bj = 0; bj < 2; ++bj) { if (bj == 0) gq[m] = *(const GAS u32x4*)(GT + gate_off(u.pm, gtile, ai, m, wr, wc, fr, fq));
                    pk[m][bj] = (u32x4){0u, 0u, 0u, 0u}; if (u.seg) pk[m][bj] = *(const GAS u32x4*)(park + frag_off(u.pm, u.pn, 8, ai, m, bj, wr, wc, fr, fq)); }
#pragma unroll
            for (int m = 0; m < 4; ++m)
#pragma unroll
                for (int bj = 0; bj < 2; ++bj) { const size_t r = (size_t)(row0 + ai * 128 + m * 16);
                    const f32x4 v0 = acc[ai][bj][m][0] * un4_u8(bj ? gq[m].z : gq[m].x) + unpk_lo(pk[m][bj]), v1 = acc[ai][bj][m][1] * un4_u8(bj ? gq[m].w : gq[m].y) + unpk_hi(pk[m][bj]);
                    if (u.seg) { const int c = col0 + bj * 128; *(GAS u32x4*)((unsigned char*)merged + ((size_t)((r >> 8) * 32 + (c >> 6)) * 256 + (r & 255)) * 128 + (c & 63) * 2) = pack8(v0, v1); }
                    else *(GAS u32x4*)(park + frag_off(u.pm, u.pn, 8, ai, m, bj, wr, wc, fr, fq)) = pack8(v0, v1); }
            asm volatile("" ::: "memory");
        }
    }
};
struct EpiHpre {
    static constexpr bool PERM = true; bf16_t* out;
    __device__ __forceinline__ void operator()(AccRef acc, const pg8::Unit& u, int wr, int wc, int fr, int fq) const {
        const int row0 = u.pm * 256 + wr * 64 + fr, col0 = u.pn * 256 + wc * 32 + 8 * fq;
#pragma unroll
        for (int ai = 0; ai < 2; ++ai)
#pragma unroll
            for (int m = 0; m < 4; ++m)
#pragma unroll
                for (int bj = 0; bj < 2; ++bj) *(GAS u32x4*)(out + tb_off((size_t)(row0 + ai * 128 + m * 16), col0 + bj * 128, 8)) = pack8(acc[ai][bj][m][0], acc[ai][bj][m][1]);
    }
};
struct EpiHid {
    static constexpr bool PERM = true; unsigned char* hid;
    __device__ __forceinline__ void operator()(AccRef acc, const pg8::Unit& u, int wr, int wc, int fr, int fq) const {
        const int row0 = u.pm * 256 + wr * 64 + fr, col0 = u.pn * 128 + wc * 32 + 8 * fq;
#pragma unroll
        for (int ai = 0; ai < 2; ++ai)
#pragma unroll
            for (int m = 0; m < 4; ++m) { const f32x4 g0 = acc[ai][0][m][0] * INV8, g1 = acc[ai][0][m][1] * INV8;
                const f32x4 v0 = g0 * sig4(g0) * acc[ai][1][m][0] * (INV8 * A8_SCALE), v1 = g1 * sig4(g1) * acc[ai][1][m][1] * (INV8 * A8_SCALE);
                u32x2 o; o.x = pk4_fp8(v0.x, v0.y, v0.z, v0.w); o.y = pk4_fp8(v1.x, v1.y, v1.z, v1.w);
                { const size_t r = (size_t)(row0 + ai * 128 + m * 16); *(GAS u32x2*)(hid + (((r >> 8) * 6 + (size_t)(col0 >> 7)) * 256 + (r & 255)) * 128 + (col0 & 127)) = o; } }
    }
};
struct EpiY {
    static constexpr bool PERM = true; bf16_t* Y; const int* TL; const float* GWp; const LAS int* cntl;
    __device__ __forceinline__ void operator()(AccRef acc, const pg8::Unit& u, int wr, int wc, int fr, int fq) const {
        const int cn = cntl[u.aux], col0 = u.pn * 256 + wc * 32 + 8 * fq;
        int asg[2][4]; float gw[2][4];
#pragma unroll
        for (int ai = 0; ai < 2; ++ai)
#pragma unroll
            for (int m = 0; m < 4; ++m) { const int idx = u.seg * 256 + ai * 128 + wr * 64 + m * 16 + fr; asg[ai][m] = TL[(size_t)u.aux * TL_CAP + (idx < cn ? idx : 0)]; if (idx >= cn) asg[ai][m] = -1; }
#pragma unroll
        for (int ai = 0; ai < 2; ++ai)
#pragma unroll
            for (int m = 0; m < 4; ++m) gw[ai][m] = GWp[asg[ai][m] >= 0 ? asg[ai][m] : 0] * INV8;
#pragma unroll
        for (int ai = 0; ai < 2; ++ai)
#pragma unroll
            for (int m = 0; m < 4; ++m)
                if (asg[ai][m] >= 0) {
#pragma unroll
                    for (int bj = 0; bj < 2; ++bj) *(GAS u32x4*)(Y + (size_t)asg[ai][m] * 2048 + col0 + bj * 128) = pack8(acc[ai][bj][m][0] * gw[ai][m], acc[ai][bj][m][1] * gw[ai][m]); }
    }
};
struct EpiPark {
    static constexpr bool PERM = true; unsigned char* park;
    __device__ __forceinline__ void operator()(AccRef acc, const pg8::Unit& u, int wr, int wc, int fr, int fq) const {
#pragma unroll
        for (int ai = 0; ai < 2; ++ai)
#pragma unroll
            for (int m = 0; m < 4; ++m)
#pragma unroll
                for (int bj = 0; bj < 2; ++bj) *(GAS u32x4*)(park + frag_off(u.pm, u.pn, 8, ai, m, bj, wr, wc, fr, fq)) = pack8(acc[ai][bj][m][0], acc[ai][bj][m][1]);
    }
};
struct EpiOut {
    static constexpr bool PERM = true; const bf16_t* x2; const unsigned char* park; const float* bias; float* out;
    __device__ __forceinline__ void operator()(AccRef acc, const pg8::Unit& u, int wr, int wc, int fr, int fq) const {
        const int row0 = u.pm * 256 + wr * 64 + fr, col0 = u.pn * 256 + wc * 32 + 8 * fq;
        f32x4 bv[2][2];
#pragma unroll
        for (int bj = 0; bj < 2; ++bj)
#pragma unroll
            for (int n = 0; n < 2; ++n) bv[bj][n] = *(const f32x4*)(bias + col0 + bj * 128 + 4 * n);
#pragma unroll
        for (int ai = 0; ai < 2; ++ai) {
            u32x4 pk[4][2], xv[4][2];
#pragma unroll
            for (int m = 0; m < 4; ++m)
#pragma unroll
                for (int bj = 0; bj < 2; ++bj) { const size_t off = (size_t)(row0 + ai * 128 + m * 16) * 2048 + col0 + bj * 128; pk[m][bj] = *(const GAS u32x4*)(park + frag_off(u.pm, u.pn, 8, ai, m, bj, wr, wc, fr, fq)); xv[m][bj] = *(const GAS u32x4*)(x2 + tb_off((size_t)(row0 + ai * 128 + m * 16), col0 + bj * 128, 8)); }
#pragma unroll
            for (int m = 0; m < 4; ++m)
#pragma unroll
                for (int bj = 0; bj < 2; ++bj) { const size_t off = (size_t)(row0 + ai * 128 + m * 16) * 2048 + col0 + bj * 128;
                    *(GAS f32x4*)(out + off) = unpk_lo(xv[m][bj]) + sig4(acc[ai][bj][m][0] * INV8 + bv[bj][0]) * unpk_lo(pk[m][bj]);
                    *(GAS f32x4*)(out + off + 4) = unpk_hi(xv[m][bj]) + sig4(acc[ai][bj][m][1] * INV8 + bv[bj][1]) * unpk_hi(pk[m][bj]); }
            asm volatile("" ::: "memory");
        }
    }
};

struct WeffSched {
    static constexpr bool GATHER = false;
    const char* A; const char* B; int G, c;
    __device__ __forceinline__ bool next(int i, pg8::Unit& u) const { const int L = i * G + c; if (L >= 32) return false; u.pm = L & 7; u.pn = L >> 3; u.seg = 0; u.aux = 0; return true; }
    __device__ __forceinline__ const char* abase(const pg8::Unit& u) const { return A + (size_t)(u.pm * 16 + u.pn * 4) * 32768; }
    __device__ __forceinline__ const char* bbase(const pg8::Unit& u) const { return B + (size_t)(u.pn * 4) * 32768; }
    __device__ __forceinline__ void gather(const pg8::Unit&, const int (&)[2], const int (&)[2], unsigned (&)[2][2]) const {}
};
struct EpiWeff {
    static constexpr bool PERM = true; unsigned char* W;
    __device__ __forceinline__ void operator()(AccRef acc, const pg8::Unit& u, int wr, int wc, int fr, int fq) const {
#pragma unroll
        for (int ai = 0; ai < 2; ++ai)
#pragma unroll
            for (int m = 0; m < 4; ++m)
#pragma unroll
                for (int bj = 0; bj < 2; ++bj) { const int r = ai * 128 + wr * 64 + m * 16 + fr, k = u.pn * 256 + bj * 128 + wc * 32 + 8 * fq;
                    *(GAS u32x4*)(W + ((size_t)(u.pm * 16 + (k >> 6)) * 256 + r) * 128 + (k & 63) * 2) = pack8(acc[ai][bj][m][0], acc[ai][bj][m][1]); }
    }
};
constexpr int N_PHASES = 12;
__global__ void __launch_bounds__(NTHREADS, 2) mk_fwd(Args args) {
    extern __shared__ __attribute__((aligned(16))) unsigned char lds_raw[];
    Frame F;
    F.lds = (LAS unsigned char*)lds_raw;
    F.tid = threadIdx.x; F.lane = F.tid & 63; F.wave = __builtin_amdgcn_readfirstlane(F.tid >> 6);
    F.G = gridDim.x; { const int bx = blockIdx.x; F.vcu = (F.G % 8 == 0) ? (bx % 8) * (F.G / 8) + bx / 8 : bx; }
    F.ws = args.ws; F.outb = (unsigned char*)args.out;
    volatile LAS unsigned* MISC = (volatile LAS unsigned*)(F.lds + LDS_MISC_OFF);
    if (F.tid < 64) MISC[F.tid] = 0u;
    __syncthreads();
    unsigned* ctl = (unsigned*)(F.ws + WS_CTL);
    XcdBarrier bar; bar.bar = ctl + CW_BAR; bar.x = 0; bar.st = nullptr;
    if (MK_N_LAUNCHES == 1) bar = xcd_barrier_post(ctl + CW_BAR, MISC + 8);
    const int lo = args.ph_lo, hi = args.ph_hi;
#ifndef PH_MASK
#define PH_MASK 0xFFF
#endif
#define IN(k) ((((PH_MASK) >> (k)) & 1) && lo <= (k) && (k) < hi)
#ifdef PROBE_PH
    unsigned long long pt0 = 0, pt1 = 0;
#define SEAM(k) do { if (IN(k) && IN((k) + 1)) xcd_barrier(bar); if ((k) + 1 == PROBE_PH) pt0 = __builtin_amdgcn_s_memrealtime(); if ((k) == PROBE_PH) pt1 = __builtin_amdgcn_s_memrealtime(); } while (0)
#else
#define SEAM(k) do { if (IN(k) && IN((k) + 1)) xcd_barrier(bar); } while (0)
#endif
    LAS unsigned char* ring = F.lds;
    const int bid = (int)blockIdx.x;

#ifdef PROBE_PH
    if (PROBE_PH == 0) pt0 = __builtin_amdgcn_s_memrealtime();
#endif
    if (IN(0)) { p0_prologue(F, args); } SEAM(0);

    if (IN(1)) {
        if (F.vcu < NBH) gate_scan(F, F.vcu);
        const int mq0 = TSTEPS_P0 + (int)(((long)((TSTEPS - TSTEPS_P0) / 4) * F.vcu) / F.G) * 4, mq1 = TSTEPS_P0 + (int)(((long)((TSTEPS - TSTEPS_P0) / 4) * (F.vcu + 1)) / F.G) * 4;
        const bool conv_first = ((bid >> 3) & 1) != 0;
        if (conv_first) transpose_range(F, args, mq0, mq1);
#pragma unroll 1
        for (int pass = 0; pass < 2; ++pass) {
            if ((pass ^ (bid & 1)) == 0) { ZSched S; S.init(F.outb + OUT_XB, F.ws + W_IN, 2048, 2048, ~(unsigned)(Z8_MASK), F.G, bid);
                EpiZ E{(bf16_t*)(F.ws + WS_Z), F.ws + WS_GT, args.in[I_BIN], 1.0f};
                pg8::gemm_phase<EpiZ, ZSched>(ring, 2048, 2048, 2048, S, E); }
            else if ((unsigned)(Z8_MASK) != 0u) { ZSched S; S.init(F.ws + WS_XF8, F.ws + W_IN8, 1024, 1024, (unsigned)(Z8_MASK), F.G, bid);
                EpiZ E{(bf16_t*)(F.ws + WS_Z), F.ws + WS_GT, args.in[I_BIN], INV8};
                pg8::gemm_phase<EpiZ, ZSched, true>(ring, 1024, 1024, 1024, S, E); }
        }
        if (!conv_first) transpose_range(F, args, mq0, mq1);
    } SEAM(1);

    if (IN(2)) {
        if (bid < 32) { WeffSched S; S.A = (const char*)(F.ws + W_PBRT); S.B = (const char*)(F.ws + W_PS); S.G = 32; S.c = bid;
            EpiWeff E{F.ws + W_EFF};
            pg8::gemm_phase<EpiWeff, WeffSched, false, true>(ring, 256, 256, 256, S, E); }
        for (int u = F.vcu; u < NBH * NCHUNK; u += F.G) mlstm_m1_unit(F, args, u >> 5, u & 31);
        pool_phase(F);
    } SEAM(2);

    if (IN(3)) { mlstm_m2(F); } SEAM(3);

    if (IN(4)) { for (int u = F.vcu; u < NBH * NCHUNK; u += F.G) mlstm_m3_unit(F, args, u >> 5, u & 31); } SEAM(4);

    if (IN(5)) {
        StaticSched S; S.init(F.outb + OUT_PU, F.outb + OUT_HG, F.ws + W_EFF, F.ws + W_MBR, 1024, 1024, T_TOK, 2048, F.G, bid, 2);
        EpiMerge E{F.ws + WS_GT, F.ws + S2_PARK, (bf16_t*)(F.ws + S2_MERGED)};
        pg8::gemm_phase<EpiMerge, StaticSched, false, true>(ring, 1024, 1024, 1024, S, E);
    } SEAM(5);

    if (IN(6)) {
        StaticSched S; S.init(F.ws + S2_MERGED, nullptr, F.ws + W_OUT, nullptr, 2048, 2048, T_TOK, 2048, F.G, bid, 1);
        EpiHpre E{(bf16_t*)(F.ws + Z_X1)};
        pg8::gemm_phase<EpiHpre, StaticSched, false, true>(ring, 2048, 2048, 2048, S, E);
    } SEAM(6);

    if (IN(7)) { ln1_router_phase(F, args); } SEAM(7);

    if (IN(8) || IN(9)) {
        LAS int* tstart = (LAS int*)(F.lds + LDS_TAB_OFF); LAS int* cntl = (LAS int*)(F.lds + LDS_TAB_OFF + 256);
        if (F.tid < N_EXPERTS) cntl[F.tid] = (int)__hip_atomic_load(ctl + CW_CNT + 64 * F.tid, RLX_AGENT);
        __syncthreads();
        if (F.tid == 0) { int s = 0; for (int e = 0; e < N_EXPERTS; ++e) { tstart[e] = s; s += (cntl[e] + 255) >> 8; } tstart[N_EXPERTS] = s; }
        __syncthreads();
        const int RT = tstart[N_EXPERTS];
        if (IN(8)) {
            MoeSched<true> S; S.tstart = tstart; S.cntl = cntl; S.Abase = (const char*)(F.ws + S2_X1F8); S.Bbase = (const char*)(F.ws + W_GU); S.TL = (const int*)(F.ws + WS_SMALL + SM_TL);
            S.estride = (size_t)1536 * 2048; S.lda = 1024; S.ldb = 1024; S.NT = 6; S.nwg = RT * 6; S.G = F.G; S.c = bid;
            EpiHid E{F.ws + S2_HID};
            pg8::gemm_phase<EpiHid, MoeSched<true>, true>(ring, 1024, 1024, 1024, S, E);
        }
        SEAM(8);
        if (IN(9)) {
            MoeSched<false> S; S.tstart = tstart; S.cntl = cntl; S.Abase = (const char*)(F.ws + S2_HID); S.Bbase = (const char*)(F.ws + W_DN); S.TL = (const int*)(F.ws + WS_SMALL + SM_TL);
            S.estride = (size_t)2048 * 768; S.lda = 384; S.ldb = 384; S.NT = 8; S.nwg = RT * 8; S.G = F.G; S.c = bid;
            EpiY E{(bf16_t*)(F.ws + Z_Y), (const int*)(F.ws + WS_SMALL + SM_TL), (const float*)(F.ws + WS_SMALL + SM_GW), cntl};
            pg8::gemm_phase<EpiY, MoeSched<false>, true, true>(ring, 384, 384, 384, S, E);
        }
    } SEAM(9);

    if (IN(10)) { ln2_phase(F, args); } SEAM(10);

    if (IN(11)) {
        { StaticSched S; S.init(F.ws + WS_PB, nullptr, F.ws + W_PP, nullptr, 256, 256, T_TOK, 2048, F.G, bid, 1);
          EpiPark E{F.ws + S2_PARK2};
          pg8::gemm_phase<EpiPark, StaticSched>(ring, 256, 256, 256, S, E); }
        { StaticSched S; S.init(F.ws + Z_X2F8, nullptr, F.ws + W_PG8, nullptr, 1024, 1024, T_TOK, 2048, F.G, bid, 1);
          EpiOut E{(const bf16_t*)(F.ws + S2_X2B), F.ws + S2_PARK2, args.in[I_BPG], args.out};
          pg8::gemm_phase<EpiOut, StaticSched, true>(ring, 1024, 1024, 1024, S, E); }
    }
#ifdef PROBE_PH
    { if (PROBE_PH == 0) pt0 = pt0 ? pt0 : 0; if (PROBE_PH == N_PHASES - 1) pt1 = __builtin_amdgcn_s_memrealtime();
      if (blockIdx.x == 0 && F.tid == 0) { const unsigned long long t2 = __builtin_amdgcn_s_memrealtime(); const unsigned long long w = (pt1 - pt0) * PROBE_MULT; while (__builtin_amdgcn_s_memrealtime() - t2 < w) __builtin_amdgcn_s_sleep(8); } }
#endif
#undef IN
#undef SEAM
}

extern "C" void kernel_launch(void* const* d_in, const int* in_sizes, int n_in, void* d_out, int out_size, void* d_ws, size_t ws_size, hipStream_t stream) {
    static int grid = 0;
    if (grid == 0) {
        if (n_in != 26 || in_sizes[0] != T_TOK * D_MODEL || out_size != T_TOK * D_MODEL || ws_size < WS_END) { fprintf(stderr, "kernel_launch: unexpected shapes (n_in %d, ws %zu)\n", n_in, ws_size); grid = -1; return; }
        int dev = 0, cus = 0;
        if (hipGetDevice(&dev) != hipSuccess || hipDeviceGetAttribute(&cus, hipDeviceAttributeMultiprocessorCount, dev) != hipSuccess) { grid = -1; return; }
        if (hipFuncSetAttribute((const void*)mk_fwd, hipFuncAttributeMaxDynamicSharedMemorySize, LDS_BYTES) != hipSuccess) { fprintf(stderr, "kernel_launch: hipFuncSetAttribute failed\n"); grid = -1; return; }
        (void)hipGetLastError();
        grid = cus;
    }
    if (grid < 0) return;
    (void)hipMemsetAsync((char*)d_ws + WS_CTL, 0, CTL_ZERO_BYTES, stream);
    Args a{};
    for (int i = 0; i < 26; ++i) a.in[i] = (const float*)d_in[i];
    a.out = (float*)d_out; a.ws = (unsigned char*)d_ws;
    if (MK_N_LAUNCHES == 1) { a.ph_lo = 0; a.ph_hi = N_PHASES; hipLaunchKernelGGL(mk_fwd, dim3(grid), dim3(NTHREADS), LDS_BYTES, stream, a); }
    else for (int li = 0; li < N_PHASES; ++li) { a.ph_lo = li; a.ph_hi = li + 1; hipLaunchKernelGGL(mk_fwd, dim3(grid), dim3(NTHREADS), LDS_BYTES, stream, a);
#ifdef PROBE_DUP
        if ((PROBE_DUP >> li) & 1) hipLaunchKernelGGL(mk_fwd, dim3(grid), dim3(NTHREADS), LDS_BYTES, stream, a);
#endif
    }
}
```

```cpp
#include <hip/hip_runtime.h>
#include <cstdio>
#include <cstdint>

#ifndef MK_N_LAUNCHES
#define MK_N_LAUNCHES 1
#endif

#define GAS __attribute__((address_space(1)))
#define LAS __attribute__((address_space(3)))
typedef unsigned short bf16_t;
typedef short bf16x8 __attribute__((ext_vector_type(8)));
typedef short s16x4 __attribute__((ext_vector_type(4)));
typedef float f32x4 __attribute__((ext_vector_type(4)));
typedef float f32x2 __attribute__((ext_vector_type(2)));
typedef unsigned u32x4 __attribute__((ext_vector_type(4)));
typedef unsigned u32x2 __attribute__((ext_vector_type(2)));

constexpr int D_MODEL = 2048, BATCH = 4, SEQ = 4096, T_TOK = BATCH * SEQ;
constexpr int PLE_DIM = 256, M_HEADS = 4, M_QK_DIM = 128, M_V_DIM = 256, M_QK = 512, M_V = 1024, CHUNK = 128, NCHUNK = SEQ / CHUNK;
constexpr int POOL_W = 1024, IN_DIM = 8200, ZW = 8192;
constexpr int N_EXPERTS = 32, EPG = 8, D_EXPERT = 768, NBH = BATCH * M_HEADS;
constexpr float LN_EPS = 1e-5f;
constexpr float ALPHA = 1.189207115002721f;
constexpr int ZC_QK = 0, ZC_V = 1024, ZC_O = 2048, ZC_U = 3072, ZC_GM = 4096, ZC_GP = 6144;
#ifndef Z8_MASK
#define Z8_MASK 0xFFFF0FFFu
#endif
__host__ __device__ constexpr bool z_is8(int pn) { return ((Z8_MASK >> pn) & 1u) != 0; }

__host__ __device__ constexpr size_t tb_off(size_t row, int col, int ntile) { return (((row >> 8) * ntile + (size_t)(col >> 8)) << 16) + ((row & 255) << 8) + (size_t)(col & 255); }
__host__ __device__ constexpr size_t ta_off(size_t row, int col, int nkt) { return (((row >> 8) * nkt + (size_t)(col >> 6)) * 256 + (row & 255)) * 128 + (size_t)(col & 63) * 2; }
constexpr int ZT = 16;

constexpr size_t MiB = 1u << 20;
constexpr size_t WS_CTL = 0, CTL_ZERO_BYTES = 128 * 1024;
constexpr size_t WS_SMALL = 1 * MiB;
constexpr size_t WS_W = 16 * MiB;
constexpr size_t W_IN = WS_W;
constexpr size_t W_EFF = W_IN + 32 * MiB;
constexpr size_t W_MBR = W_EFF + 4 * MiB;
constexpr size_t W_OUT = W_MBR + 4 * MiB;
constexpr size_t W_PG = W_OUT + 8 * MiB;
constexpr size_t W_PBRT = W_PG;
constexpr size_t W_PS = W_PG + 4 * MiB;
constexpr size_t W_PP = W_PG + 8 * MiB;
constexpr size_t W_RT = W_PP + 1 * MiB;
constexpr int RT_WBLK = 2304;
constexpr size_t W_GU = W_RT + 1 * MiB;
constexpr size_t W_DN = W_GU + 96 * MiB;
constexpr size_t W_PG8 = W_DN + 48 * MiB;
constexpr size_t WS_PB = W_PG8 + 4 * MiB;
constexpr size_t WS_Z = WS_PB + 8 * MiB;
constexpr size_t WS_S2 = WS_Z + 256 * MiB;
constexpr size_t W_IN8 = WS_S2 + 128 * MiB;
constexpr size_t WS_XF8 = W_IN8 + 16 * MiB;
constexpr size_t WS_GT = WS_XF8 + 32 * MiB;
constexpr size_t WS_END = WS_GT + 128 * MiB;
constexpr size_t S2_DKV = WS_S2, S2_CST = WS_S2 + 72 * MiB;
constexpr size_t S2_PARK = WS_S2, S2_MERGED = WS_S2 + 64 * MiB;
constexpr size_t S2_X1B = WS_S2, S2_X1F8 = WS_S2 + 64 * MiB, S2_HID = WS_S2 + 96 * MiB;
constexpr size_t S2_X2B = WS_Z, S2_PARK2 = WS_GT + 64 * MiB;
constexpr int NSCAN_MIN = (16 * (257 * 128 / 8) + 511) / 512;
constexpr size_t Z_X1 = WS_Z, Z_Y = WS_Z + 128 * MiB;
constexpr size_t Z_X2F8 = WS_S2 + 128 * MiB + 16 * MiB;
constexpr size_t OUT_XB = 0, OUT_PU = 64 * MiB, OUT_HG = 96 * MiB;
constexpr size_t SM_GATES = 0;
constexpr size_t SM_AT = 1 * MiB;
constexpr size_t SM_MR = SM_AT + 256 * 1024;
constexpr size_t SM_EM = SM_MR + 256 * 1024;
constexpr size_t SM_MC = SM_EM + 256 * 1024;
constexpr size_t SM_ML = SM_MC + 4096;
constexpr size_t SM_DEC = SM_ML + 4096;
constexpr size_t SM_TL = 3 * MiB;
constexpr size_t SM_GW = 7 * MiB;
constexpr int TL_CAP = 32768;
static_assert(SM_GW + 4 * MiB <= 15 * MiB, "small region");
constexpr int CW_BAR = 4096;
constexpr int CW_CNT = 16384;

constexpr int RING_BYTES = 131072;
constexpr int LDS_BYTES = 163840;
constexpr int LDS_MISC_OFF = LDS_BYTES - 256;
constexpr int LDS_USABLE = LDS_MISC_OFF;

constexpr int NWAVES = 8, NTHREADS = 512;

#define RLX_AGENT __ATOMIC_RELAXED, __HIP_MEMORY_SCOPE_AGENT
__device__ __forceinline__ unsigned cvt_pk_bf16(float lo, float hi) { unsigned r; asm volatile("v_cvt_pk_bf16_f32 %0, %1, %2" : "=v"(r) : "v"(lo), "v"(hi)); return r; }
__device__ __forceinline__ unsigned pk4_fp8(float a, float b, float c, float d) { int p = __builtin_amdgcn_cvt_pk_fp8_f32(a, b, 0, false); p = __builtin_amdgcn_cvt_pk_fp8_f32(c, d, p, true); return (unsigned)p; }
__device__ __forceinline__ unsigned pk4_u8(const f32x4 v) {
    unsigned p = __builtin_amdgcn_cvt_pk_u8_f32(floorf(v.x * 255.0f + 0.5f), 0, 0u); p = __builtin_amdgcn_cvt_pk_u8_f32(floorf(v.y * 255.0f + 0.5f), 1, p);
    p = __builtin_amdgcn_cvt_pk_u8_f32(floorf(v.z * 255.0f + 0.5f), 2, p); return __builtin_amdgcn_cvt_pk_u8_f32(floorf(v.w * 255.0f + 0.5f), 3, p); }
__device__ __forceinline__ f32x4 un4_u8(unsigned q) { return (f32x4){(float)(q & 0xffu), (float)((q >> 8) & 0xffu), (float)((q >> 16) & 0xffu), (float)(q >> 24)} * (1.0f / 255.0f); }
__device__ __forceinline__ u32x4 pack8(const f32x4 a, const f32x4 b) { u32x4 w; w.x = cvt_pk_bf16(a.x, a.y); w.y = cvt_pk_bf16(a.z, a.w); w.z = cvt_pk_bf16(b.x, b.y); w.w = cvt_pk_bf16(b.z, b.w); return w; }
__device__ __forceinline__ float bf_lo(unsigned w) { return __uint_as_float(w << 16); }
__device__ __forceinline__ float bf_hi(unsigned w) { return __uint_as_float(w & 0xffff0000u); }
__device__ __forceinline__ f32x4 unpk_lo(const u32x4 u) { return (f32x4){bf_lo(u.x), bf_hi(u.x), bf_lo(u.y), bf_hi(u.y)}; }
__device__ __forceinline__ f32x4 unpk_hi(const u32x4 u) { return (f32x4){bf_lo(u.z), bf_hi(u.z), bf_lo(u.w), bf_hi(u.w)}; }
__device__ __forceinline__ float bf2f(bf16_t h) { return __uint_as_float(((unsigned)h) << 16); }
__device__ __forceinline__ float fast_exp(float x) { return __builtin_amdgcn_exp2f(x * 1.44269504088896f); }
__device__ __forceinline__ float sigmoidf_(float x) { return __builtin_amdgcn_rcpf(1.0f + fast_exp(-x)); }
__device__ __forceinline__ float wave_sum(float v) {
#pragma unroll
    for (int o = 1; o < 64; o <<= 1) v += __shfl_xor(v, o);
    return v;
}

#define XB_TMO      128
#define XB_XCNT(j)  (256  + 64 * (j))
#define XB_XSUB(j)  (1280 + 64 * (j))
#define XB_XGEN(j)  (2304 + 64 * (j))
#define XB_TOP      3328
#define XB_TOPGEN   3392
#define XCD_BAR_WORDS 3456
#define XB_SPIN_CAP (1u << 20)
__device__ __forceinline__ unsigned xb_ld(unsigned* p)              { return __hip_atomic_load(p, __ATOMIC_RELAXED, __HIP_MEMORY_SCOPE_AGENT); }
__device__ __forceinline__ unsigned xb_add(unsigned* p, unsigned v) { return __hip_atomic_fetch_add(p, v, __ATOMIC_RELAXED, __HIP_MEMORY_SCOPE_AGENT); }
__device__ __forceinline__ unsigned xb_xcc_id() { return (unsigned)__builtin_amdgcn_s_getreg((3 << 11) | 20) & 0xFu; }
#define XB_SPIN(cond, bar) do { unsigned _sp = 0; while (cond) { __builtin_amdgcn_s_sleep(1); \
    if ((++_sp & 255u) == 0u) { if (xb_ld(&(bar)[XB_TMO])) break; if (_sp > XB_SPIN_CAP) { atomicAdd(&(bar)[XB_TMO], 1u); break; } } } } while (0)
struct XcdBarrier { unsigned* bar; unsigned x; volatile LAS unsigned* st; };
__device__ __forceinline__ XcdBarrier xcd_barrier_post(unsigned* bar, volatile LAS unsigned* st) {
    XcdBarrier b; b.bar = bar; b.x = xb_xcc_id(); b.st = st;
    if (threadIdx.x == 0) (void)xb_add(&bar[XB_XCNT(b.x)], 1u);
    return b;
}
__device__ __forceinline__ void xcd_barrier_complete(unsigned* bar, unsigned x, unsigned& nloc, unsigned& nx) {
    const unsigned G = gridDim.x * gridDim.y * gridDim.z;
    unsigned sum, cnt, mine, sp = 0u;
    for (;;) {
        sum = 0u; cnt = 0u; mine = 0u;
#pragma unroll
        for (unsigned j = 0; j < 16; ++j) { const unsigned c = xb_ld(&bar[XB_XCNT(j)]); sum += c; cnt += (c > 0u) ? 1u : 0u; mine = (j == x) ? c : mine; }
        if (sum == G) break;
        __builtin_amdgcn_s_sleep(1);
        if ((++sp & 255u) == 0u) { if (xb_ld(&bar[XB_TMO])) break; if (sp > XB_SPIN_CAP) { atomicAdd(&bar[XB_TMO], 1u); break; } }
    }
    nloc = mine > 0u ? mine : 1u; nx = cnt > 0u ? cnt : 1u;
}
__device__ __forceinline__ void xcd_barrier(const XcdBarrier& b) {
    asm volatile("s_waitcnt vmcnt(0)" ::: "memory");
    __syncthreads();
    if (threadIdx.x == 0) {
        unsigned* bar = b.bar;
        __builtin_amdgcn_s_waitcnt(0);
        unsigned nloc = b.st[0], nx = b.st[1];
        if (nloc == 0u) { xcd_barrier_complete(bar, b.x, nloc, nx); b.st[0] = nloc; b.st[1] = nx; }
        const unsigned old = xb_add(&bar[XB_XSUB(b.x)], 1u);
        const unsigned gen = old / nloc;
        if (old + 1u == (gen + 1u) * nloc) {
            __builtin_amdgcn_fence(__ATOMIC_RELEASE, "agent");
            asm volatile("s_waitcnt vmcnt(0)" ::: "memory");
            const unsigned og = xb_add(&bar[XB_TOP], 1u);
            const unsigned tg = og / nx;
            if (og + 1u == (tg + 1u) * nx) xb_add(&bar[XB_TOPGEN], 1u);
            else XB_SPIN(xb_ld(&bar[XB_TOPGEN]) == tg, bar);
            __builtin_amdgcn_fence(__ATOMIC_ACQUIRE, "agent");
            xb_add(&bar[XB_XGEN(b.x)], 1u);
            asm volatile("s_waitcnt vmcnt(0)" ::: "memory");
        } else {
            XB_SPIN(xb_ld(&bar[XB_XGEN(b.x)]) == gen, bar);
            __builtin_amdgcn_fence(__ATOMIC_ACQUIRE, "agent");
            asm volatile("s_waitcnt vmcnt(0)" ::: "memory");
        }
    }
    __syncthreads();
}

namespace pg8 {
constexpr int BM = 256, BK = 64, HALF = 128, HTB = HALF * BK * 2, STAGE_BYTES = 8 * HTB, NXCD = 8, WGM = 8;
__host__ __device__ __forceinline__ int lds_byte(int r, int c) { const int st = (r >> 4) * 2 + (c >> 5), rr = r & 15, cc = c & 31, ob = rr * 64 + cc * 2; return st * 1024 + (ob ^ (((ob >> 9) & 1) << 5)); }
__host__ __device__ __forceinline__ void stage_rc(int b, int& R, int& C) { const int st = b / 1024, sb = b % 1024, swz = sb ^ (((sb >> 9) & 1) << 5); R = (st >> 1) * 16 + swz / 64; C = (st & 1) * 32 + (swz % 64) / 2; }
__host__ __device__ __forceinline__ int perm32(int rho) { const int n = rho >> 4, i = rho & 15; return 8 * (i >> 2) + 4 * n + (i & 3); }

typedef int i32x8 __attribute__((ext_vector_type(8)));
typedef int i32x4 __attribute__((ext_vector_type(4)));
__device__ __forceinline__ bf16x8 lo8(const i32x8 v) { return __builtin_bit_cast(bf16x8, (i32x4){v[0], v[1], v[2], v[3]}); }
__device__ __forceinline__ bf16x8 hi8(const i32x8 v) { return __builtin_bit_cast(bf16x8, (i32x4){v[4], v[5], v[6], v[7]}); }
struct Unit { int pm, pn, seg, aux; };

__device__ __forceinline__ int xcd_remap(int wgid, int nwg) { const int q = nwg / NXCD, r = nwg % NXCD, xcd = wgid % NXCD, off = wgid / NXCD; return (xcd < r ? xcd * (q + 1) : r * (q + 1) + (xcd - r) * q) + off; }
__device__ __forceinline__ void tile_of(int wgid, int nM, int nN, int& pm, int& pn) { const int nig = WGM * nN, gid = wgid / nig, fm = gid * WGM, gsz = (nM - fm) < WGM ? (nM - fm) : WGM; pm = fm + ((wgid % nig) % gsz); pn = (wgid % nig) / gsz; }

template <class Epi, class Sched, bool FP8 = false, bool ATILED = false>
__device__ __forceinline__ void gemm_phase(LAS unsigned char* lds, const int K, const int lda, const int ldb, const Sched& S, const Epi& E) {
    const int tid = threadIdx.x, wid = __builtin_amdgcn_readfirstlane(tid >> 6), lane = tid & 63, wr = wid >> 2, wc = wid & 3, fr = lane & 15, fq = lane >> 4;
    const int nt = K / BK;
    int Rr[2], Cc[2];
    unsigned voffA[2], voffB[2];
#pragma unroll
    for (int i = 0; i < 2; ++i) { int R, C; stage_rc(tid * 16 + i * 8192, R, C); Rr[i] = R; Cc[i] = C; const int Rb = Epi::PERM ? ((R & ~31) + perm32(R & 31)) : R;
        voffA[i] = ATILED ? (unsigned)(R * 128 + C * 2) : (unsigned)(R * lda + C) * 2u; voffB[i] = (unsigned)(Rb * 128 + C * 2); }
    const size_t kstep = ATILED ? (size_t)32768 : (size_t)(BK * 2);
    const size_t hstepA = ATILED ? (size_t)HALF * 128 : (size_t)HALF * lda * 2, hstepB = (size_t)HALF * 128, kstepB = 32768; (void)ldb;
    const unsigned ldsw = (unsigned)wid * 1024u;
    const int aoff = lds_byte(wr * 64 + fr, fq * 8), boff = lds_byte(wc * 32 + fr, fq * 8);
#define PG8_SA(b, h) (((b) * 2 + (h)) * HTB)
#define PG8_SB(b, h) ((4 + (b) * 2 + (h)) * HTB)
#define PG8_STAGE(bufoff, gbase, voff) do { _Pragma("unroll") for (int _i = 0; _i < 2; ++_i) \
        __builtin_amdgcn_global_load_lds((const unsigned*)((const char*)(gbase) + (voff)[_i]), (LAS unsigned*)(lds + (bufoff) + ldsw + _i * 8192), 16, 0, 0); } while (0)
#define PG8_STAGE_A(bufoff, p, h, vo) do { if constexpr (Sched::GATHER) { PG8_STAGE(bufoff, p, (vo)[h]); } else { PG8_STAGE(bufoff, (p) + (h) * hstepA, voffA); } } while (0)
#define PG8_LDA(dst, b, h) do { _Pragma("unroll") for (int m = 0; m < 4; ++m) { const i32x4 _lo = *(const LAS i32x4*)(lds + PG8_SA(b, h) + aoff + m * 2048), _hi = *(const LAS i32x4*)(lds + PG8_SA(b, h) + aoff + m * 2048 + 1024); \
        dst[m] = (i32x8){_lo[0], _lo[1], _lo[2], _lo[3], _hi[0], _hi[1], _hi[2], _hi[3]}; } } while (0)
#define PG8_LDB(dst, b, h) do { _Pragma("unroll") for (int n = 0; n < 2; ++n) { const i32x4 _lo = *(const LAS i32x4*)(lds + PG8_SB(b, h) + boff + n * 2048), _hi = *(const LAS i32x4*)(lds + PG8_SB(b, h) + boff + n * 2048 + 1024); \
        dst[n] = (i32x8){_lo[0], _lo[1], _lo[2], _lo[3], _hi[0], _hi[1], _hi[2], _hi[3]}; } } while (0)
#define PG8_MMA(ai, bj, At, Bt) do { __builtin_amdgcn_s_setprio(1); _Pragma("unroll") for (int m = 0; m < 4; ++m) _Pragma("unroll") for (int n = 0; n < 2; ++n) { \
        if constexpr (FP8) { asm volatile("v_mfma_scale_f32_16x16x128_f8f6f4 %0, %1, %2, %0, %3, %3 op_sel_hi:[0,0,0]" : "+v"(acc[ai][bj][m][n]) : "v"(Bt[n]), "v"(At[m]), "v"(scale1)); } \
        else { acc[ai][bj][m][n] = __builtin_amdgcn_mfma_f32_16x16x32_bf16(lo8(Bt[n]), lo8(At[m]), acc[ai][bj][m][n], 0, 0, 0); acc[ai][bj][m][n] = __builtin_amdgcn_mfma_f32_16x16x32_bf16(hi8(Bt[n]), hi8(At[m]), acc[ai][bj][m][n], 0, 0, 0); } } __builtin_amdgcn_s_setprio(0); } while (0)
#define PG8_WAIT_V(n) asm volatile("s_waitcnt vmcnt(" #n ")" ::: "memory")
#define PG8_WAIT_L(n) asm volatile("s_waitcnt lgkmcnt(" #n ")" ::: "memory")
#define PG8_BAR __builtin_amdgcn_s_barrier()
#define PG8_SCHED __builtin_amdgcn_sched_barrier(0)
    Unit cur, nxt; int ui = 0;
    if (!S.next(0, cur)) return;
    const int scale1 = 0x7f7f7f7f;
    f32x4 acc[2][2][4][2];
#pragma unroll
    for (int a = 0; a < 2; ++a)
#pragma unroll
        for (int b = 0; b < 2; ++b)
#pragma unroll
            for (int m = 0; m < 4; ++m)
#pragma unroll
                for (int n = 0; n < 2; ++n) acc[a][b][m][n] = (f32x4){0.f, 0.f, 0.f, 0.f};
    i32x8 At[4], B0[2], B1[2];
    unsigned vgc[2][2], vgn[2][2];
    const char* cA = S.abase(cur); const char* cB = S.bbase(cur);
    if constexpr (Sched::GATHER) { S.gather(cur, Rr, Cc, vgc); }
    PG8_STAGE(PG8_SB(0, 0), cB, voffB); PG8_STAGE(PG8_SB(0, 1), cB + hstepB, voffB); PG8_STAGE_A(PG8_SA(0, 0), cA, 0, vgc); PG8_STAGE_A(PG8_SA(0, 1), cA, 1, vgc);
    if (wr == 1) PG8_BAR;
    PG8_WAIT_V(2); PG8_BAR;
    PG8_STAGE(PG8_SB(1, 0), cB + kstepB, voffB); PG8_STAGE_A(PG8_SA(1, 0), cA + kstep, 0, vgc); PG8_STAGE(PG8_SB(1, 1), cB + hstepB + kstepB, voffB);
    PG8_WAIT_V(6); PG8_BAR;
    for (;;) {
        const bool has_next = S.next(ui + 1, nxt);
        const char* nA = has_next ? S.abase(nxt) : cA; const char* nB = has_next ? S.bbase(nxt) : cB;
        if constexpr (Sched::GATHER) { if (has_next) S.gather(nxt, Rr, Cc, vgn); else {
#pragma unroll
            for (int h = 0; h < 2; ++h)
#pragma unroll
                for (int i = 0; i < 2; ++i) vgn[h][i] = vgc[h][i]; } }
#pragma unroll 1
        for (int t = 0; t < nt; t += 2) {
            const bool last = (t == nt - 2);
            const char* a1 = cA + (size_t)(t + 1) * kstep;
            const char* a2 = last ? nA : cA + (size_t)(t + 2) * kstep; const char* b2 = last ? nB : cB + (size_t)(t + 2) * kstepB;
            const char* a3 = a2 + kstep; const char* b3 = b2 + kstepB;
            unsigned vg2[2][2];
            if constexpr (Sched::GATHER) {
#pragma unroll
                for (int h = 0; h < 2; ++h)
#pragma unroll
                    for (int i = 0; i < 2; ++i) vg2[h][i] = last ? vgn[h][i] : vgc[h][i]; }
            PG8_LDB(B0, 0, 0); PG8_LDB(B1, 0, 1); PG8_SCHED; PG8_LDA(At, 0, 0); PG8_STAGE_A(PG8_SA(1, 1), a1, 1, vgc);
            PG8_WAIT_V(8); PG8_WAIT_L(0); PG8_BAR; PG8_MMA(0, 0, At, B0); PG8_MMA(0, 1, At, B1); PG8_BAR; PG8_SCHED;
            PG8_LDA(At, 0, 1); PG8_STAGE(PG8_SB(0, 0), b2, voffB); PG8_STAGE(PG8_SB(0, 1), b2 + hstepB, voffB); PG8_STAGE_A(PG8_SA(0, 0), a2, 0, vg2);
            PG8_WAIT_V(8); PG8_WAIT_L(0); PG8_BAR; PG8_MMA(1, 0, At, B0); PG8_MMA(1, 1, At, B1); PG8_BAR; PG8_SCHED;
            PG8_LDB(B0, 1, 0); PG8_LDB(B1, 1, 1); PG8_SCHED; PG8_LDA(At, 1, 0); PG8_STAGE_A(PG8_SA(0, 1), a2, 1, vg2);
            PG8_WAIT_V(8); PG8_WAIT_L(0); PG8_BAR; PG8_MMA(0, 0, At, B0); PG8_MMA(0, 1, At, B1); PG8_BAR; PG8_SCHED;
            PG8_LDA(At, 1, 1); PG8_STAGE(PG8_SB(1, 0), b3, voffB); PG8_STAGE(PG8_SB(1, 1), b3 + hstepB, voffB); PG8_STAGE_A(PG8_SA(1, 0), a3, 0, vg2);
            PG8_WAIT_V(8); PG8_WAIT_L(0); PG8_BAR; PG8_MMA(1, 0, At, B0); PG8_MMA(1, 1, At, B1); PG8_BAR; PG8_SCHED;
        }
        if (wr == 0) PG8_BAR;
        if constexpr (FP8) { asm volatile("s_nop 15\n\ts_nop 15" ::: "memory"); }
        bool keep = false;
        if constexpr (Epi::INPLACE) { keep = E.first_segment(cur); if (keep) E.rescale(acc, cur, wr, wc, fr, fq); else E(acc, cur, wr, wc, fr, fq); }
        else E(acc, cur, wr, wc, fr, fq);
        if (!has_next) break;
        if (!keep) {
#pragma unroll
        for (int a = 0; a < 2; ++a)
#pragma unroll
            for (int b = 0; b < 2; ++b)
#pragma unroll
                for (int m = 0; m < 4; ++m)
#pragma unroll
                    for (int n = 0; n < 2; ++n) acc[a][b][m][n] = (f32x4){0.f, 0.f, 0.f, 0.f};
        }
        cur = nxt; cA = nA; cB = nB; ++ui;
        if constexpr (Sched::GATHER) {
#pragma unroll
            for (int h = 0; h < 2; ++h)
#pragma unroll
                for (int i = 0; i < 2; ++i) vgc[h][i] = vgn[h][i]; }
        if (wr == 1) PG8_BAR;
    }
    PG8_WAIT_V(0);
    PG8_BAR;
#undef PG8_SA
#undef PG8_SB
#undef PG8_STAGE
#undef PG8_STAGE_A
#undef PG8_LDA
#undef PG8_LDB
#undef PG8_MMA
#undef PG8_WAIT_V
#undef PG8_WAIT_L
#undef PG8_BAR
#undef PG8_SCHED
}
}

struct Args { const float* in[26]; float* out; unsigned char* ws; int ph_lo, ph_hi; };
enum { I_X = 0, I_P, I_WIN, I_BIN, I_CONVW, I_CONVB, I_MHG, I_WPOOL, I_PSCALE, I_WMBR, I_WPBR, I_WOUT, I_LN1G, I_LN1B, I_WRG, I_BRG, I_WRE, I_BRE, I_WGATE, I_WUP, I_WDOWN, I_LN2G, I_LN2B, I_WPG, I_BPG, I_WPP };

struct Frame {
    LAS unsigned char* lds;
    int tid, lane, wave, vcu, G;
    unsigned char* ws; unsigned char* outb;
};

struct TStep { const float* src; int ldw; unsigned char* dst; int nkt, f8, ks, drow0, inter, nks; };
__device__ __forceinline__ void tstep_decode(const Args& args, unsigned char* ws, int g, TStep& t) {
    constexpr int C1 = 32 * 64, C2 = C1 + 8 * 32, C3 = C2 + 8 * 64, C4 = C3 + 8 * 64, C5 = C4 + 8 * 8, C6 = C5 + 96 * 64, C7 = C6 + 96 * 64, C8 = C7 + 256 * 24;
    t.inter = 0; t.f8 = 0; t.nks = 64;
    if (g < C1) { const int sp = g >> 6, ks = g & 63; t.ks = ks; t.src = args.in[I_WIN] + (size_t)(32 * ks) * IN_DIM + 256 * sp + (sp >= 12 ? 8 : 0); t.ldw = IN_DIM; t.drow0 = 256 * sp;
        if (z_is8(sp)) { t.f8 = 1; t.dst = ws + W_IN8; t.nkt = 16; } else { t.dst = ws + W_IN; t.nkt = 32; } }
    else if (g < C2) { const int q = g - C1, sp = q >> 5, ks = q & 31; t.ks = ks; t.nks = 32; t.src = args.in[I_WMBR] + (size_t)(32 * ks) * 2048 + 256 * sp; t.ldw = 2048; t.dst = ws + W_MBR; t.nkt = 16; t.drow0 = 256 * sp; }
    else if (g < C3) { const int q = g - C2, sp = q >> 6, ks = q & 63; t.ks = ks; t.src = args.in[I_WOUT] + (size_t)(32 * ks) * 2048 + 256 * sp; t.ldw = 2048; t.dst = ws + W_OUT; t.nkt = 32; t.drow0 = 256 * sp; }
    else if (g < C4) { const int q = g - C3, sp = q >> 6, ks = q & 63; t.ks = ks; t.src = args.in[I_WPG] + (size_t)(32 * ks) * 2048 + 256 * sp; t.ldw = 2048; t.dst = ws + W_PG8; t.nkt = 16; t.drow0 = 256 * sp; t.f8 = 1; }
    else if (g < C5) { const int q = g - C4, sp = q >> 3, ks = q & 7; t.ks = ks; t.nks = 8; t.src = args.in[I_WPP] + (size_t)(32 * ks) * 2048 + 256 * sp; t.ldw = 2048; t.dst = ws + W_PP; t.nkt = 4; t.drow0 = 256 * sp; }
    else if (g < C7) { const int up = g >= C6, q = g - (up ? C6 : C5), st = q >> 6, ks = q & 63, e = st / 3, sp = st % 3; t.ks = ks;
        t.src = args.in[up ? I_WUP : I_WGATE] + (size_t)e * 2048 * 768 + (size_t)(32 * ks) * 768 + 256 * sp; t.ldw = 768; t.dst = ws + W_GU; t.nkt = 16; t.drow0 = e * 1536 + (up ? 128 : 0); t.inter = 1 + sp; t.f8 = 1; }
    else if (g < C8) { const int q = g - C7, st = q / 24, ks = q % 24, e = st >> 3, sp = st & 7; t.ks = ks; t.nks = 24;
        t.src = args.in[I_WDOWN] + (size_t)e * 768 * 2048 + (size_t)(32 * ks) * 2048 + 256 * sp; t.ldw = 2048; t.dst = ws + W_DN; t.nkt = 6; t.drow0 = e * 2048 + 256 * sp; t.f8 = 1; }
    else { const int q = g - C8, sp = q >> 5, ks = q & 31; t.ks = ks; t.nks = 32; t.src = args.in[I_WPBR] + (size_t)(32 * ks) * 2048 + 256 * sp; t.ldw = 2048; t.dst = ws + W_PBRT; t.nkt = 16; t.drow0 = 256 * sp; }
}
constexpr int TSTEPS = 32 * 64 + 8 * 32 + 8 * 64 + 8 * 64 + 8 * 8 + 96 * 64 * 2 + 256 * 24 + 8 * 32;
constexpr int TSTEPS_P0 = 32 * 64;
constexpr float W8_SCALE = 64.0f, A8_SCALE = 16.0f, INV8 = 1.0f / (64.0f * 16.0f);
constexpr int TS_NSLOT = 7, TS_SLOTB = 16384, TS_STAGE = TS_NSLOT * TS_SLOTB, TS_RSTRIDE = 144;
static_assert(TS_STAGE + 256 * TS_RSTRIDE <= LDS_USABLE, "transposer LDS map");
template <bool F8>
__device__ __forceinline__ void transpose_segment(const TStep& t, const int nst, LAS unsigned char* lds, int wave, int lane, int tid) {
    const int nh = 2 * nst;
    const float* psrc = t.src + (size_t)wave * t.ldw + 4 * lane;
    const size_t hstep = (size_t)16 * t.ldw, r8 = (size_t)8 * t.ldw;
    int islot = 0;
#pragma unroll 1
    for (int p = 0; p < TS_NSLOT - 1; ++p) if (p < nh) {
        __builtin_amdgcn_global_load_lds((const unsigned*)psrc, (LAS unsigned*)(lds + islot * TS_SLOTB + wave * 1024), 16, 0, 0);
        __builtin_amdgcn_global_load_lds((const unsigned*)(psrc + r8), (LAS unsigned*)(lds + islot * TS_SLOTB + (wave + 8) * 1024), 16, 0, 0);
        psrc += hstep; islot = islot == TS_NSLOT - 1 ? 0 : islot + 1; }
    const int nl = lane >> 1, kq = lane & 1, n = 32 * wave + nl;
    constexpr int GS = F8 ? 8 : 4, SEG = 128 / GS;
    const LAS float* rd = (const LAS float*)lds + n + 8 * kq * 256;
    LAS unsigned char* st = lds + TS_STAGE + n * TS_RSTRIDE + kq * (SEG / 2);
    int slot = 0, sub = (2 * t.ks) & (GS - 1), kt = (2 * t.ks) / GS;
#pragma unroll 1
    for (int h = 0; h < nh; ++h) {
        const int later = (nh - 1 - h) < (TS_NSLOT - 2) ? (nh - 1 - h) : (TS_NSLOT - 2);
        if (later >= 5) asm volatile("s_waitcnt vmcnt(10)" ::: "memory"); else if (later == 4) asm volatile("s_waitcnt vmcnt(8)" ::: "memory"); else if (later == 3) asm volatile("s_waitcnt vmcnt(6)" ::: "memory");
        else if (later == 2) asm volatile("s_waitcnt vmcnt(4)" ::: "memory"); else if (later == 1) asm volatile("s_waitcnt vmcnt(2)" ::: "memory"); else asm volatile("s_waitcnt vmcnt(0)" ::: "memory");
        __builtin_amdgcn_s_barrier(); asm volatile("" ::: "memory");
        if (h + TS_NSLOT - 1 < nh) {
            __builtin_amdgcn_global_load_lds((const unsigned*)psrc, (LAS unsigned*)(lds + islot * TS_SLOTB + wave * 1024), 16, 0, 0);
            __builtin_amdgcn_global_load_lds((const unsigned*)(psrc + r8), (LAS unsigned*)(lds + islot * TS_SLOTB + (wave + 8) * 1024), 16, 0, 0);
            psrc += hstep; islot = islot == TS_NSLOT - 1 ? 0 : islot + 1; }
        const LAS float* sl = rd + slot * (TS_SLOTB / 4);
        float v[8];
#pragma unroll
        for (int j = 0; j < 8; ++j) v[j] = sl[j * 256];
        if (F8) { u32x2 o; o.x = pk4_fp8(v[0] * W8_SCALE, v[1] * W8_SCALE, v[2] * W8_SCALE, v[3] * W8_SCALE); o.y = pk4_fp8(v[4] * W8_SCALE, v[5] * W8_SCALE, v[6] * W8_SCALE, v[7] * W8_SCALE);
            *(LAS u32x2*)(st + sub * SEG) = o; }
        else { u32x4 o; o.x = cvt_pk_bf16(v[0], v[1]); o.y = cvt_pk_bf16(v[2], v[3]); o.z = cvt_pk_bf16(v[4], v[5]); o.w = cvt_pk_bf16(v[6], v[7]);
            *(LAS u32x4*)(st + sub * SEG) = o; }
        if (sub == GS - 1) {
            asm volatile("s_waitcnt lgkmcnt(0)" ::: "memory"); __builtin_amdgcn_s_barrier(); asm volatile("" ::: "memory");
#pragma unroll
            for (int i = 0; i < 4; ++i) { const int c = tid + 512 * i, row = c >> 3, ch = c & 7;
                int drow = t.drow0 + row; if (t.inter) { const int nn = 256 * (t.inter - 1) + row; drow = t.drow0 + (nn >> 7) * 256 + (nn & 127); }
                const u32x4 vv = *(const LAS u32x4*)(lds + TS_STAGE + row * TS_RSTRIDE + ch * 16);
                *(GAS u32x4*)(t.dst + ((size_t)((drow >> 8) * t.nkt + kt) * 256 + (drow & 255)) * 128 + ch * 16) = vv; }
            sub = 0; ++kt;
        } else ++sub;
        slot = slot == TS_NSLOT - 1 ? 0 : slot + 1;
    }
    asm volatile("s_waitcnt vmcnt(0) lgkmcnt(0)" ::: "memory");
    __builtin_amdgcn_s_barrier(); asm volatile("" ::: "memory");
}
__device__ __forceinline__ void transpose_range(Frame& F, const Args& args, const int g0, const int g1) {
    unsigned char* ws = F.ws;
#pragma unroll 1
    for (int g = g0; g < g1;) {
        TStep t; tstep_decode(args, ws, g, t);
        const int nst = (t.nks - t.ks) < (g1 - g) ? (t.nks - t.ks) : (g1 - g);
        if (t.f8) transpose_segment<true>(t, nst, F.lds, F.wave, F.lane, F.tid); else transpose_segment<false>(t, nst, F.lds, F.wave, F.lane, F.tid);
        g += nst;
    }
    __syncthreads();
}

__device__ __forceinline__ void p0_prologue(Frame& F, const Args& args) {
    unsigned char* ws = F.ws;
    const int gw = F.vcu * NWAVES + F.wave, NGW = F.G * NWAVES;
    { const int q0 = (int)(((long)(TSTEPS_P0 / 4) * F.vcu) / F.G) * 4, q1 = (int)(((long)(TSTEPS_P0 / 4) * (F.vcu + 1)) / F.G) * 4; transpose_range(F, args, q0, q1); }
    {
        const float* wpool = args.in[I_WPOOL]; const float* ps = args.in[I_PSCALE]; unsigned char* wps = ws + W_PS;
        const int gt = F.vcu * NTHREADS + F.tid, NGT = F.G * NTHREADS;
        for (int idx = gt; idx < 4 * 256 * 32; idx += NGT) {
            const int d0 = (idx & 31) * 8, kk = (idx >> 5) & 255, g = idx >> 13;
            const f32x4 w0 = *(const f32x4*)(wpool + ((size_t)g * 256 + kk) * 256 + d0), w1 = *(const f32x4*)(wpool + ((size_t)g * 256 + kk) * 256 + d0 + 4);
            const f32x4 p0 = *(const f32x4*)(ps + g * 256 + d0), p1 = *(const f32x4*)(ps + g * 256 + d0 + 4);
            *(GAS u32x4*)(wps + ((size_t)(g * 4 + (d0 >> 6)) * 256 + kk) * 128 + (d0 & 63) * 2) = pack8(w0 * p0, w1 * p1);
        }
    }
    {
        bf16_t* wr = (bf16_t*)(ws + W_RT);
        const int gt = F.vcu * NTHREADS + F.tid, NGT = F.G * NTHREADS;
        for (int idx = gt; idx < 36 * 2048; idx += NGT) { const int n = idx >> 11, k = idx & 2047;
            const float w = n < 4 ? args.in[I_WRG][k * 4 + n] : args.in[I_WRE][k * 32 + (n - 4)];
            const unsigned hi = cvt_pk_bf16(w, 0.f) & 0xffffu; const float lo = w - __uint_as_float(hi << 16);
            const int t = n >> 4, r = n & 15, q = (k >> 3) & 3, j = k & 7; const size_t base = (size_t)(k >> 5) * RT_WBLK;
            const size_t o = t < 2 ? base + (size_t)((t * 2) * 64 + q * 16 + r) * 8 + j : base + 2048 + (size_t)(q * 4 + r) * 8 + j;
            wr[o] = (bf16_t)hi; wr[o + (t < 2 ? 512 : 128)] = (bf16_t)(cvt_pk_bf16(lo, 0.f) & 0xffffu); }
        const f32x4* p4 = (const f32x4*)args.in[I_P]; u32x2* pb = (u32x2*)(ws + WS_PB);
        for (int i0 = gt; i0 < T_TOK * PLE_DIM / 4; i0 += 8 * NGT) {
            f32x4 v[8];
#pragma unroll
            for (int k = 0; k < 8; ++k) { const int idx = i0 + k * NGT; v[k] = p4[idx < T_TOK * PLE_DIM / 4 ? idx : i0]; }
#pragma unroll
            for (int k = 0; k < 8; ++k) { const int idx = i0 + k * NGT; u32x2 o; o.x = cvt_pk_bf16(v[k].x, v[k].y); o.y = cvt_pk_bf16(v[k].z, v[k].w); if (idx < T_TOK * PLE_DIM / 4) pb[idx] = o; } }
    }
    {
        __syncthreads();
        LAS float* wg = (LAS float*)F.lds;
        for (int e = F.tid; e < 2048; e += NTHREADS) { const f32x4 a = *(const GAS f32x4*)(args.in[I_WIN] + (size_t)e * IN_DIM + 3072), b = *(const GAS f32x4*)(args.in[I_WIN] + (size_t)e * IN_DIM + 3076);
            wg[0 * 2048 + e] = a.x; wg[1 * 2048 + e] = a.y; wg[2 * 2048 + e] = a.z; wg[3 * 2048 + e] = a.w; wg[4 * 2048 + e] = b.x; wg[5 * 2048 + e] = b.y; wg[6 * 2048 + e] = b.z; wg[7 * 2048 + e] = b.w; }
        __syncthreads();
        const float* x = args.in[I_X]; bf16_t* xb = (bf16_t*)(F.outb + OUT_XB); float* gates = (float*)(ws + WS_SMALL + SM_GATES);
        const float bgate = args.in[I_BIN][3072 + (F.lane & 7)];
        for (int row = gw; row < T_TOK; row += NGW) {
            float g[8];
#pragma unroll
            for (int c = 0; c < 8; ++c) g[c] = 0.f;
#pragma unroll
            for (int itx = 0; itx < 4; ++itx) {
                const int e0 = itx * 512 + F.lane * 8;
                const f32x4 v0 = *(const GAS f32x4*)(x + (size_t)row * 2048 + e0), v1 = *(const GAS f32x4*)(x + (size_t)row * 2048 + e0 + 4);
                u32x4 o; o.x = cvt_pk_bf16(v0.x, v0.y); o.y = cvt_pk_bf16(v0.z, v0.w); o.z = cvt_pk_bf16(v1.x, v1.y); o.w = cvt_pk_bf16(v1.z, v1.w);
                *(GAS u32x4*)(xb + (size_t)row * 2048 + e0) = o;
                { u32x2 f8; f8.x = pk4_fp8(v0.x * A8_SCALE, v0.y * A8_SCALE, v0.z * A8_SCALE, v0.w * A8_SCALE); f8.y = pk4_fp8(v1.x * A8_SCALE, v1.y * A8_SCALE, v1.z * A8_SCALE, v1.w * A8_SCALE); *(GAS u32x2*)(ws + WS_XF8 + (size_t)row * 2048 + e0) = f8; }
#pragma unroll
                for (int c = 0; c < 8; ++c) { const f32x4 w0 = *(const LAS f32x4*)(wg + c * 2048 + e0), w1 = *(const LAS f32x4*)(wg + c * 2048 + e0 + 4);
                    g[c] += (v0.x * w0.x + v0.y * w0.y) + (v0.z * w0.z + v0.w * w0.w) + (v1.x * w1.x + v1.y * w1.y) + (v1.z * w1.z + v1.w * w1.w); }
            }
#pragma unroll
            for (int c = 0; c < 8; ++c) g[c] = wave_sum(g[c]);
            if (F.lane < 8) { float s = g[0];
#pragma unroll
                for (int c = 1; c < 8; ++c) s = (F.lane == c) ? g[c] : s;
                gates[(size_t)row * 8 + F.lane] = s + bgate; }
        }
        __syncthreads();
    }
}

__device__ __forceinline__ void gate_scan(Frame& F, int bh) {
    unsigned char* ws = F.ws;
    const int b = bh >> 2, h = bh & 3, tid = F.tid, lane = F.lane;
    const float* gates = (const float*)(ws + WS_SMALL + SM_GATES);
    LAS float* sA = (LAS float*)F.lds; LAS float* sB = sA + 32; LAS float* sMC = sA + 64; LAS float* sML = sA + 96;
    float ig[8], bb[8], aa[8];
    float run = 0.f;
#pragma unroll
    for (int i = 0; i < 8; ++i) { const size_t t = (size_t)b * SEQ + tid * 8 + i; ig[i] = gates[t * 8 + h]; const float fg = gates[t * 8 + 4 + h];
        const float lf = fminf(fg, 0.f) - log1pf(expf(-fabsf(fg))); run += lf; bb[i] = run; }
    const float tot = run; float v = tot;
#pragma unroll
    for (int off = 1; off < 16; off <<= 1) { const float n = __shfl_up(v, off, 16); if ((lane & 15) >= off) v += n; }
    const float excl = v - tot;
    float amax = -INFINITY;
#pragma unroll
    for (int i = 0; i < 8; ++i) { bb[i] += excl; aa[i] = ig[i] - bb[i]; amax = fmaxf(amax, aa[i]); }
    float gmax = amax;
#pragma unroll
    for (int off = 1; off < 16; off <<= 1) gmax = fmaxf(gmax, __shfl_xor(gmax, off, 16));
    const float blast = __shfl(bb[7], 15, 16);
    const int chunk = tid >> 4;
    if ((tid & 15) == 0) { sA[chunk] = gmax; sB[chunk] = blast; }
    __syncthreads();
    if (tid == 0) { float m = 0.f; for (int c = 0; c < NCHUNK; ++c) { sMC[c] = m; const float Ml = fmaxf(m, sA[c]); sML[c] = Ml; m = sB[c] + Ml; } }
    __syncthreads();
    const float mc = sMC[chunk];
    float pm = amax;
#pragma unroll
    for (int off = 1; off < 16; off <<= 1) { const float n = __shfl_up(pm, off, 16); if ((lane & 15) >= off) pm = fmaxf(pm, n); }
    float ex = __shfl_up(pm, 1, 16); if ((lane & 15) == 0) ex = -INFINITY;
    float cm = fmaxf(mc, ex);
    float* AT = (float*)(ws + WS_SMALL + SM_AT) + (size_t)bh * SEQ + tid * 8; float* MRp = (float*)(ws + WS_SMALL + SM_MR) + (size_t)bh * SEQ + tid * 8; float* EMp = (float*)(ws + WS_SMALL + SM_EM) + (size_t)bh * SEQ + tid * 8;
#pragma unroll
    for (int i = 0; i < 8; ++i) { cm = fmaxf(cm, aa[i]); AT[i] = aa[i]; MRp[i] = cm; EMp[i] = expf(-(bb[i] + cm)); }
    if (tid < NCHUNK) { ((float*)(ws + WS_SMALL + SM_MC))[bh * NCHUNK + tid] = sMC[tid]; ((float*)(ws + WS_SMALL + SM_ML))[bh * NCHUNK + tid] = sML[tid];
        ((float*)(ws + WS_SMALL + SM_DEC))[bh * NCHUNK + tid] = expf(sMC[tid] - sML[tid]); }
    __syncthreads();
}

__device__ __forceinline__ bf16x8 tr_frag(const LAS unsigned char* base, int stride, int row0, int col0, int lane) {
    const int g = lane >> 4, q = (lane & 15) >> 2, p = lane & 3;
    const LAS unsigned char* a = base + (row0 + 8 * g + q) * stride + (col0 + 4 * p) * 2;
    const s16x4 lo = __builtin_amdgcn_ds_read_tr16_b64_v4i16((LAS s16x4*)a);
    const s16x4 hi = __builtin_amdgcn_ds_read_tr16_b64_v4i16((LAS s16x4*)(a + 4 * stride));
    bf16x8 r; r[0] = lo[0]; r[1] = lo[1]; r[2] = lo[2]; r[3] = lo[3]; r[4] = hi[0]; r[5] = hi[1]; r[6] = hi[2]; r[7] = hi[3]; return r;
}
__device__ __forceinline__ bf16x8 row_frag(const LAS unsigned char* base, int stride, int row0, int col0, int lane) {
    return *(const LAS bf16x8*)(base + (row0 + (lane & 15)) * stride + (col0 + 8 * (lane >> 4)) * 2);
}
constexpr int QK_STRIDE = 272;
constexpr int V_STRIDE = 560;
constexpr int MS_QS = 0, MS_KS = 34816, MS_XS = 69632, MS_SMALL = MS_XS + 73984;
constexpr int MS_CW = MS_SMALL + 2560;
static_assert(MS_CW + 5120 <= LDS_USABLE, "mLSTM LDS map");

__device__ __forceinline__ void conv_load(Frame& F, u32x4 (&u)[7], int zcol0, size_t t0, bool first) {
    const bf16_t* Z = (const bf16_t*)(F.ws + WS_Z);
    const int ch = F.tid & 15, r0 = F.tid >> 4;
#pragma unroll
    for (int k = 0; k < 7; ++k) { const int lr = 4 * r0 - 3 + k; const bool dead = first && lr < 0;
        const u32x4 t = *(const GAS u32x4*)(Z + tb_off((size_t)((long)t0 + (dead ? 0 : lr)), zcol0 + ch * 8, ZT));
        u[k] = (u32x4){dead ? 0u : t.x, dead ? 0u : t.y, dead ? 0u : t.z, dead ? 0u : t.w}; }
}
__device__ __forceinline__ void cw_load(Frame& F, const Args& args, float (&cwv)[2], int zcol0) {
#pragma unroll
    for (int k = 0; k < 2; ++k) { const int i = F.tid + k * NTHREADS, ii = i < 640 ? i : 0, r = ii >> 7, zc = zcol0 + (ii & 127);
        const float* src = r < 4 ? args.in[I_CONVW] + r * 1024 + zc : args.in[I_CONVB] + zc; cwv[k] = *src; }
}
__device__ __forceinline__ void cw_store(Frame& F, LAS float* dst, const float (&cwv)[2]) {
    dst[F.tid] = cwv[0]; if (F.tid + NTHREADS < 640) dst[F.tid + NTHREADS] = cwv[1];
}
__device__ __forceinline__ void conv_store(Frame& F, const LAS float* cwl, LAS unsigned char* dst, const u32x4 (&u)[7], float scale) {
    const int ch = F.tid & 15, r0 = F.tid >> 4;
    float w[4][8], bias[8];
#pragma unroll
    for (int tap = 0; tap < 4; ++tap) { const f32x4 a = *(const LAS f32x4*)(cwl + tap * 128 + ch * 8), b = *(const LAS f32x4*)(cwl + tap * 128 + ch * 8 + 4);
        w[tap][0] = a.x; w[tap][1] = a.y; w[tap][2] = a.z; w[tap][3] = a.w; w[tap][4] = b.x; w[tap][5] = b.y; w[tap][6] = b.z; w[tap][7] = b.w; }
    { const f32x4 a = *(const LAS f32x4*)(cwl + 512 + ch * 8), b = *(const LAS f32x4*)(cwl + 512 + ch * 8 + 4); bias[0] = a.x; bias[1] = a.y; bias[2] = a.z; bias[3] = a.w; bias[4] = b.x; bias[5] = b.y; bias[6] = b.z; bias[7] = b.w; }
#pragma unroll
    for (int i = 0; i < 4; ++i) {
        const int l = 4 * r0 + i;
        float o[8];
#pragma unroll
        for (int j = 0; j < 8; ++j) o[j] = bias[j];
#pragma unroll
        for (int tap = 0; tap < 4; ++tap) {
            const u32x4 v = u[i + tap];
            o[0] += w[tap][0] * bf_lo(v.x); o[1] += w[tap][1] * bf_hi(v.x); o[2] += w[tap][2] * bf_lo(v.y); o[3] += w[tap][3] * bf_hi(v.y);
            o[4] += w[tap][4] * bf_lo(v.z); o[5] += w[tap][5] * bf_hi(v.z); o[6] += w[tap][6] * bf_lo(v.w); o[7] += w[tap][7] * bf_hi(v.w);
        }
#pragma unroll
        for (int j = 0; j < 8; ++j) o[j] = o[j] * sigmoidf_(o[j]) * scale;
        u32x4 pk; pk.x = cvt_pk_bf16(o[0], o[1]); pk.y = cvt_pk_bf16(o[2], o[3]); pk.z = cvt_pk_bf16(o[4], o[5]); pk.w = cvt_pk_bf16(o[6], o[7]);
        *(LAS u32x4*)(dst + l * QK_STRIDE + ch * 16) = pk;
    }
}
__device__ __forceinline__ void load_v_tile(Frame& F, u32x4 (&vv)[8], int zcol0, size_t t0) {
    const bf16_t* Z = (const bf16_t*)(F.ws + WS_Z);
    const int ch = F.tid & 31, r0 = F.tid >> 5;
#pragma unroll
    for (int i = 0; i < 8; ++i) vv[i] = *(const GAS u32x4*)(Z + tb_off(t0 + r0 + 16 * i, zcol0 + ch * 8, ZT));
}
__device__ __forceinline__ void store_v_tile(Frame& F, LAS unsigned char* dst, const u32x4 (&vv)[8], const LAS float* wl) {
    const int ch = F.tid & 31, r0 = F.tid >> 5;
#pragma unroll
    for (int i = 0; i < 8; ++i) {
        const int l = r0 + 16 * i;
        const u32x4 u = vv[i];
        u32x4 pk = u;
        if (wl) { const float w = wl[l];
            pk.x = cvt_pk_bf16(w * bf_lo(u.x), w * bf_hi(u.x)); pk.y = cvt_pk_bf16(w * bf_lo(u.y), w * bf_hi(u.y)); pk.z = cvt_pk_bf16(w * bf_lo(u.z), w * bf_hi(u.z)); pk.w = cvt_pk_bf16(w * bf_lo(u.w), w * bf_hi(u.w)); }
        *(LAS u32x4*)(dst + l * V_STRIDE + ch * 16) = pk;
    }
    if (F.tid < 128) { const float w = wl ? wl[F.tid] : 1.0f; u32x4 a = (u32x4){cvt_pk_bf16(w, 0.f), 0u, 0u, 0u}; const u32x4 z = (u32x4){0u, 0u, 0u, 0u};
        *(LAS u32x4*)(dst + F.tid * V_STRIDE + 512) = a; *(LAS u32x4*)(dst + F.tid * V_STRIDE + 528) = z; }
}

__device__ __forceinline__ void mlstm_m1_unit(Frame& F, const Args& args, int bh, int c) {
    const int b = bh >> 2, h = bh & 3, lane = F.lane, w = F.wave;
    const size_t t0 = (size_t)b * SEQ + c * CHUNK;
    LAS unsigned char* KS = F.lds + MS_KS; LAS unsigned char* XS = F.lds + MS_XS; LAS float* wl = (LAS float*)(F.lds + MS_SMALL);
    u32x4 uk[7]; conv_load(F, uk, ZC_QK + M_QK + h * M_QK_DIM, t0, c == 0);
    u32x4 vv[8]; load_v_tile(F, vv, ZC_V + h * M_V_DIM, t0);
    { const float a = ((const float*)(F.ws + WS_SMALL + SM_AT))[(size_t)bh * SEQ + c * CHUNK + (F.tid & 127)]; const float Ml = ((const float*)(F.ws + WS_SMALL + SM_ML))[bh * NCHUNK + c]; if (F.tid < 128) wl[F.tid] = fast_exp(a - Ml); }
    { float cwk[2]; cw_load(F, args, cwk, ZC_QK + M_QK + h * M_QK_DIM); cw_store(F, (LAS float*)(F.lds + MS_CW), cwk); }
    __syncthreads();
    conv_store(F, (const LAS float*)(F.lds + MS_CW), KS, uk, 0.08838834764831845f);
    __syncthreads();
    store_v_tile(F, XS, vv, wl);
    __syncthreads();
    f32x4 acc[17];
#pragma unroll
    for (int i = 0; i < 17; ++i) acc[i] = (f32x4){0.f, 0.f, 0.f, 0.f};
#pragma unroll
    for (int ks = 0; ks < 4; ++ks) {
        const bf16x8 kf = tr_frag(KS, QK_STRIDE, 32 * ks, 16 * w, lane);
#pragma unroll
        for (int cv = 0; cv < 17; ++cv) { const bf16x8 vf = tr_frag(XS, V_STRIDE, 32 * ks, 16 * cv, lane); acc[cv] = __builtin_amdgcn_mfma_f32_16x16x32_bf16(kf, vf, acc[cv], 0, 0, 0); }
    }
    bf16_t* dkv = (bf16_t*)(F.ws + S2_DKV) + (size_t)(bh * NCHUNK + c) * 272 * 128;
    { const int q4 = lane >> 4, odd = q4 & 1;
#pragma unroll
      for (int p = 0; p < 8; ++p) {
          const f32x4 snd = odd ? acc[2 * p] : acc[2 * p + 1], own = odd ? acc[2 * p + 1] : acc[2 * p];
          f32x4 rx; rx.x = __shfl_xor(snd.x, 16); rx.y = __shfl_xor(snd.y, 16); rx.z = __shfl_xor(snd.z, 16); rx.w = __shfl_xor(snd.w, 16);
          const f32x4 lo = odd ? rx : own, hi = odd ? own : rx;
          const int v = 32 * p + 16 * odd + (lane & 15), d0 = 16 * w + 4 * (q4 & 2);
          *(GAS u32x4*)(dkv + (size_t)v * 128 + d0) = pack8(lo, hi); }
      if ((lane & 15) == 0) { u32x2 o; o.x = cvt_pk_bf16(acc[16].x, acc[16].y); o.y = cvt_pk_bf16(acc[16].z, acc[16].w); *(GAS u32x2*)(dkv + (size_t)256 * 128 + 16 * w + 4 * q4) = o; } }
    __syncthreads();
}

__device__ __forceinline__ void mlstm_m2(Frame& F, int sidx, int nscan) {
    const int gt = sidx * NTHREADS + F.tid, NGT = nscan * NTHREADS;
    constexpr int Q8 = 257 * 128 / 8, CS8 = 272 * 128 / 8;
    const float* dec = (const float*)(F.ws + WS_SMALL + SM_DEC);
    for (int it = gt; it < NBH * Q8; it += NGT) {
        const int bh = it / Q8, q = it % Q8;
        const u32x4* src = (const u32x4*)(F.ws + S2_DKV) + (size_t)bh * NCHUNK * CS8 + q;
        u32x4* dst = (u32x4*)(F.ws + S2_CST) + (size_t)bh * NCHUNK * CS8 + q;
        f32x4 C0 = (f32x4){0.f, 0.f, 0.f, 0.f}, C1 = C0;
        u32x4 d[NCHUNK]; float dc[NCHUNK];
#pragma unroll
        for (int c = 0; c < NCHUNK; ++c) { d[c] = *(const GAS u32x4*)(src + (size_t)c * CS8); dc[c] = dec[bh * NCHUNK + c]; }
#pragma unroll
        for (int c = 0; c < NCHUNK; ++c) {
            *(GAS u32x4*)(dst + (size_t)c * CS8) = pack8(C0, C1);
            C0 = C0 * dc[c] + unpk_lo(d[c]); C1 = C1 * dc[c] + unpk_hi(d[c]);
        }
    }
}

__device__ __forceinline__ void mlstm_m3_unit(Frame& F, const Args& args, int bh, int c) {
    const int b = bh >> 2, h = bh & 3, lane = F.lane, w = F.wave, tid = F.tid;
    const size_t t0 = (size_t)b * SEQ + c * CHUNK;
    LAS unsigned char* QS = F.lds + MS_QS; LAS unsigned char* KS = F.lds + MS_KS; LAS unsigned char* XS = F.lds + MS_XS;
    LAS float* sa = (LAS float*)(F.lds + MS_SMALL); LAS float* smr = sa + 128; LAS float* sem = sa + 256; LAS float* sg = sa + 384;
    const float mc = ((const float*)(F.ws + WS_SMALL + SM_MC))[bh * NCHUNK + c];
    u32x4 uq[7], uk[7], cv_[9];
    conv_load(F, uq, ZC_QK + h * M_QK_DIM, t0, c == 0);
    conv_load(F, uk, ZC_QK + M_QK + h * M_QK_DIM, t0, c == 0);
    { const u32x4* cst = (const u32x4*)(F.ws + S2_CST) + (size_t)(bh * NCHUNK + c) * (272 * 128 / 8);
#pragma unroll
      for (int k = 0; k < 9; ++k) { const int it = tid + k * NTHREADS, r = it >> 4; const bool live = it < 272 * 16 && r <= 256; const u32x4 t = cst[live ? it : 0]; cv_[k] = (u32x4){live ? t.x : 0u, live ? t.y : 0u, live ? t.z : 0u, live ? t.w : 0u}; } }
    { const size_t o = (size_t)bh * SEQ + c * CHUNK + (tid & 127);
      const float a_ = ((const float*)(F.ws + WS_SMALL + SM_AT))[o], mr_ = ((const float*)(F.ws + WS_SMALL + SM_MR))[o], em_ = ((const float*)(F.ws + WS_SMALL + SM_EM))[o];
      if (tid < 128) { sa[tid] = a_; smr[tid] = mr_; sem[tid] = em_; } }
    { int go = 4 * (tid & 63); asm volatile("" : "+v"(go));
      const f32x4 gq = *(const f32x4*)(args.in[I_MHG] + h * M_V_DIM + go); if (tid < 64) *(LAS f32x4*)(sg + 4 * tid) = gq; }
    { float cwq[2], cwk[2]; cw_load(F, args, cwq, ZC_QK + h * M_QK_DIM); cw_load(F, args, cwk, ZC_QK + M_QK + h * M_QK_DIM);
      cw_store(F, (LAS float*)(F.lds + MS_CW), cwq); cw_store(F, (LAS float*)(F.lds + MS_CW) + 640, cwk); }
    __syncthreads();
    conv_store(F, (const LAS float*)(F.lds + MS_CW), QS, uq, 1.0f);
    conv_store(F, (const LAS float*)(F.lds + MS_CW) + 640, KS, uk, 0.08838834764831845f);
#pragma unroll
    for (int k = 0; k < 9; ++k) { const int it = tid + k * NTHREADS, r = it >> 4, ch = it & 15; if (it < 272 * 16) *(LAS u32x4*)(XS + r * QK_STRIDE + ch * 16) = cv_[k]; }
    __syncthreads();
    u32x4 vv[8]; load_v_tile(F, vv, ZC_V + h * M_V_DIM, t0);
    const int j = 16 * w + (lane & 15);
    const float mrj = smr[j], emj = sem[j], spj = expf(mc - mrj);
    bf16x8 qf[4];
#pragma unroll
    for (int ks = 0; ks < 4; ++ks) qf[ks] = row_frag(QS, QK_STRIDE, 16 * w, 32 * ks, lane);
    f32x4 st[8];
#pragma unroll
    for (int lt = 0; lt < 8; ++lt) { st[lt] = (f32x4){0.f, 0.f, 0.f, 0.f};
        if (lt <= w) {
#pragma unroll
            for (int ks = 0; ks < 4; ++ks) { const bf16x8 kf = row_frag(KS, QK_STRIDE, 16 * lt, 32 * ks, lane); st[lt] = __builtin_amdgcn_mfma_f32_16x16x32_bf16(kf, qf[ks], st[lt], 0, 0, 0); } } }
    f32x4 acc[17];
#pragma unroll
    for (int cv = 0; cv < 17; ++cv) { acc[cv] = (f32x4){0.f, 0.f, 0.f, 0.f};
#pragma unroll
        for (int ks = 0; ks < 4; ++ks) { const bf16x8 cf = row_frag(XS, QK_STRIDE, 16 * cv, 32 * ks, lane); acc[cv] = __builtin_amdgcn_mfma_f32_16x16x32_bf16(cf, qf[ks], acc[cv], 0, 0, 0); }
        acc[cv] = acc[cv] * spj; }
    __syncthreads();
#pragma unroll
    for (int lt = 0; lt < 8; ++lt) {
        const int l0 = 16 * lt + 4 * (lane >> 4);
        u32x2 pk = (u32x2){0u, 0u};
        if (lt <= w) { float e[4]; const f32x4 a4 = *(const LAS f32x4*)(sa + l0);
#pragma unroll
            for (int r = 0; r < 4; ++r) { const float f = fast_exp(a4[r] - mrj); e[r] = (lt < w || (l0 + r) <= j) ? st[lt][r] * f : 0.f; }
            pk.x = cvt_pk_bf16(e[0], e[1]); pk.y = cvt_pk_bf16(e[2], e[3]); }
        *(LAS u32x2*)(KS + j * QK_STRIDE + l0 * 2) = pk;
    }
    store_v_tile(F, XS, vv, nullptr);
    __syncthreads();
#pragma unroll
    for (int ks = 0; ks < 4; ++ks) {
        if (ks <= (w >> 1)) { const bf16x8 sf = row_frag(KS, QK_STRIDE, 16 * w, 32 * ks, lane);
#pragma unroll
            for (int cv = 0; cv < 17; ++cv) { const bf16x8 vf = tr_frag(XS, V_STRIDE, 32 * ks, 16 * cv, lane); acc[cv] = __builtin_amdgcn_mfma_f32_16x16x32_bf16(vf, sf, acc[cv], 0, 0, 0); } } }
    const bf16_t* Zo = (const bf16_t*)(F.ws + WS_Z) + tb_off(t0 + j, ZC_O + h * M_V_DIM, ZT) + 4 * (lane >> 4);
    u32x2 so[16];
#pragma unroll
    for (int cv = 0; cv < 16; ++cv) so[cv] = *(const GAS u32x2*)(Zo + 16 * cv);
    const float den = __shfl(acc[16].x, lane & 15);
    const float inv = 1.0f / fmaxf(fabsf(den), emj);
    float s = 0.f;
#pragma unroll
    for (int cv = 0; cv < 16; ++cv) { acc[cv] = acc[cv] * inv; s += (acc[cv].x + acc[cv].y) + (acc[cv].z + acc[cv].w); }
    s += __shfl_xor(s, 16); s += __shfl_xor(s, 32);
    const float mu = s * (1.0f / 256.0f);
    float q = 0.f;
#pragma unroll
    for (int cv = 0; cv < 16; ++cv) { const f32x4 d = acc[cv] - mu; q += (d.x * d.x + d.y * d.y) + (d.z * d.z + d.w * d.w); }
    q += __shfl_xor(q, 16); q += __shfl_xor(q, 32);
    const float rstd = 1.0f / sqrtf(q * (1.0f / 256.0f) + LN_EPS);
    bf16_t* HG = (bf16_t*)(F.outb + OUT_HG);
    const size_t t = t0 + j;
#pragma unroll
    for (int cv = 0; cv < 16; ++cv) { const int v = h * M_V_DIM + 16 * cv + 4 * (lane >> 4);
        const f32x4 g = *(const LAS f32x4*)(sg + 16 * cv + 4 * (lane >> 4)); const u32x2 so_ = so[cv];
        const f32x4 d = (acc[cv] - mu) * rstd;
        u32x2 o; o.x = cvt_pk_bf16(d.x * g.x * bf_lo(so_.x), d.y * g.y * bf_hi(so_.x)); o.y = cvt_pk_bf16(d.z * g.z * bf_lo(so_.y), d.w * g.w * bf_hi(so_.y));
        *(GAS u32x2*)((unsigned char*)HG + ta_off(t, v, 16)) = o; }
    __syncthreads();
}

template <int WIN>
__device__ __forceinline__ void pool_item(const bf16_t* Z, bf16_t* PU, size_t t0, int tb0, int col) {
    u32x4 u[15 + WIN];
#pragma unroll
    for (int k = 0; k < 15 + WIN; ++k) { const int rel = k - (WIN - 1); u[k] = (u32x4){0u, 0u, 0u, 0u}; if (tb0 + rel >= 0) u[k] = *(const GAS u32x4*)(Z + tb_off((size_t)((long)t0 + rel), ZC_U + col, ZT)); }
    float sum[8];
#pragma unroll
    for (int j = 0; j < 8; ++j) sum[j] = 0.f;
#pragma unroll
    for (int k = 0; k < WIN - 1; ++k) { sum[0] += bf_lo(u[k].x); sum[1] += bf_hi(u[k].x); sum[2] += bf_lo(u[k].y); sum[3] += bf_hi(u[k].y); sum[4] += bf_lo(u[k].z); sum[5] += bf_hi(u[k].z); sum[6] += bf_lo(u[k].w); sum[7] += bf_hi(u[k].w); }
#pragma unroll
    for (int r = 0; r < 16; ++r) {
        const u32x4 c = u[r + WIN - 1]; const int tb = tb0 + r;
        const float cur[8] = {bf_lo(c.x), bf_hi(c.x), bf_lo(c.y), bf_hi(c.y), bf_lo(c.z), bf_hi(c.z), bf_lo(c.w), bf_hi(c.w)};
        const float rc = 1.0f / (float)((tb + 1) < WIN ? (tb + 1) : WIN);
        float o[8];
#pragma unroll
        for (int j = 0; j < 8; ++j) { sum[j] += cur[j]; o[j] = sum[j] * rc - cur[j]; }
        u32x4 pk; pk.x = cvt_pk_bf16(o[0], o[1]); pk.y = cvt_pk_bf16(o[2], o[3]); pk.z = cvt_pk_bf16(o[4], o[5]); pk.w = cvt_pk_bf16(o[6], o[7]);
        *(GAS u32x4*)((unsigned char*)PU + ta_off(t0 + r, col, 16)) = pk;
        const u32x4 v = u[r];
        sum[0] -= bf_lo(v.x); sum[1] -= bf_hi(v.x); sum[2] -= bf_lo(v.y); sum[3] -= bf_hi(v.y); sum[4] -= bf_lo(v.z); sum[5] -= bf_hi(v.z); sum[6] -= bf_lo(v.w); sum[7] -= bf_hi(v.w);
    }
}
__device__ __forceinline__ void pool_phase(Frame& F) {
    const int gw = F.vcu * NWAVES + F.wave, NGW = F.G * NWAVES;
    const bf16_t* Z = (const bf16_t*)(F.ws + WS_Z); bf16_t* PU = (bf16_t*)(F.outb + OUT_PU);
    for (int wi = gw; wi < (T_TOK / 32) * 4; wi += NGW) {
        const int g = wi & 3, run = (wi >> 2) * 2 + (F.lane >> 5), col = g * 256 + (F.lane & 31) * 8;
        const size_t t0 = (size_t)run * 16; const int tb0 = (int)(t0 & (SEQ - 1));
        if (g == 0) pool_item<2>(Z, PU, t0, tb0, col); else if (g == 1) pool_item<4>(Z, PU, t0, tb0, col); else if (g == 2) pool_item<8>(Z, PU, t0, tb0, col); else pool_item<16>(Z, PU, t0, tb0, col);
    }
}

constexpr int RT_XSTRIDE = 4112;
constexpr int RT_XL = 16 * RT_XSTRIDE, RT_LG = 2 * RT_XL, RT_GB = RT_LG + 3072, RT_BIAS = RT_GB + 16384;
static_assert(RT_BIAS + 256 <= LDS_USABLE, "router LDS map");
__device__ __forceinline__ void ln1_router_phase(Frame& F, const Args& args) {
    const int lane = F.lane, w = F.wave, tid = F.tid;
    const bf16_t* HB = (const bf16_t*)(F.ws + Z_X1); const bf16_t* xin = (const bf16_t*)(F.outb + OUT_XB); bf16_t* X1B = (bf16_t*)(F.ws + S2_X1B); unsigned char* X1F8 = F.ws + S2_X1F8;
    const bf16_t* WR = (const bf16_t*)(F.ws + W_RT) + (size_t)(w * 8) * RT_WBLK + lane * 8; const int l2 = 2048 + ((lane >> 4) * 4 + (lane & 3)) * 8 - lane * 8;
    unsigned* cnt = (unsigned*)(F.ws + WS_CTL) + CW_CNT; int* TL = (int*)(F.ws + WS_SMALL + SM_TL); float* GWp = (float*)(F.ws + WS_SMALL + SM_GW);
    LAS unsigned char* XH = F.lds; LAS unsigned char* XL = F.lds + RT_XL; LAS f32x4* red = (LAS f32x4*)F.lds; LAS float* lg = (LAS float*)(F.lds + RT_LG);
    u32x4 xq[2][4], hq[2][4];
#define LN1_LOAD(G_) do { _Pragma("unroll") for (int rr = 0; rr < 2; ++rr) { const size_t row_ = (size_t)(G_) * 16 + 2 * w + rr; _Pragma("unroll") for (int i = 0; i < 4; ++i) { const int e0 = i * 512 + lane * 8; \
        xq[rr][i] = *(const GAS u32x4*)(xin + row_ * 2048 + e0); hq[rr][i] = *(const GAS u32x4*)(HB + tb_off(row_, e0, 8)); } } } while (0)
    if (F.vcu < T_TOK / 16) LN1_LOAD(F.vcu);
    LAS float* gbl = (LAS float*)(F.lds + RT_GB); LAS float* bias = (LAS float*)(F.lds + RT_BIAS);
    { *(LAS f32x4*)(gbl + 4 * tid) = *(const f32x4*)(args.in[I_LN1G] + 4 * tid); *(LAS f32x4*)(gbl + 2048 + 4 * tid) = *(const f32x4*)(args.in[I_LN1B] + 4 * tid);
      if (tid < 36) bias[tid] = tid < 4 ? args.in[I_BRG][tid] : args.in[I_BRE][tid - 4]; }
    __syncthreads();
    for (int grp = F.vcu; grp < T_TOK / 16; grp += F.G) {
        float v[2][32];
#pragma unroll
        for (int rr = 0; rr < 2; ++rr)
#pragma unroll
            for (int i = 0; i < 4; ++i) { const u32x4 xx = xq[rr][i]; const f32x4 a = (f32x4){bf_lo(xx.x), bf_hi(xx.x), bf_lo(xx.y), bf_hi(xx.y)}, b = (f32x4){bf_lo(xx.z), bf_hi(xx.z), bf_lo(xx.w), bf_hi(xx.w)}; const u32x4 hh = hq[rr][i];
                v[rr][8 * i + 0] = ALPHA * a.x + bf_lo(hh.x); v[rr][8 * i + 1] = ALPHA * a.y + bf_hi(hh.x); v[rr][8 * i + 2] = ALPHA * a.z + bf_lo(hh.y); v[rr][8 * i + 3] = ALPHA * a.w + bf_hi(hh.y);
                v[rr][8 * i + 4] = ALPHA * b.x + bf_lo(hh.z); v[rr][8 * i + 5] = ALPHA * b.y + bf_hi(hh.z); v[rr][8 * i + 6] = ALPHA * b.z + bf_lo(hh.w); v[rr][8 * i + 7] = ALPHA * b.w + bf_hi(hh.w); }
#pragma unroll
        for (int rr = 0; rr < 2; ++rr) {
            const int lr = 2 * w + rr; const size_t row = (size_t)grp * 16 + lr;
            float s = 0.f;
#pragma unroll
            for (int i = 0; i < 32; ++i) s += v[rr][i];
            const float mean = wave_sum(s) * (1.0f / 2048.0f); float q = 0.f;
#pragma unroll
            for (int i = 0; i < 32; ++i) { v[rr][i] -= mean; q += v[rr][i] * v[rr][i]; }
            const float rstd = 1.0f / sqrtf(wave_sum(q) * (1.0f / 2048.0f) + LN_EPS);
#pragma unroll
            for (int i = 0; i < 4; ++i) { const int e0 = i * 512 + lane * 8; float y[8];
                { const f32x4 g0 = *(const LAS f32x4*)(gbl + e0), g1 = *(const LAS f32x4*)(gbl + e0 + 4), b0 = *(const LAS f32x4*)(gbl + 2048 + e0), b1 = *(const LAS f32x4*)(gbl + 2048 + e0 + 4);
                  y[0] = v[rr][8 * i + 0] * rstd * g0.x + b0.x; y[1] = v[rr][8 * i + 1] * rstd * g0.y + b0.y; y[2] = v[rr][8 * i + 2] * rstd * g0.z + b0.z; y[3] = v[rr][8 * i + 3] * rstd * g0.w + b0.w;
                  y[4] = v[rr][8 * i + 4] * rstd * g1.x + b1.x; y[5] = v[rr][8 * i + 5] * rstd * g1.y + b1.y; y[6] = v[rr][8 * i + 6] * rstd * g1.z + b1.z; y[7] = v[rr][8 * i + 7] * rstd * g1.w + b1.w; }
                u32x4 hi; hi.x = cvt_pk_bf16(y[0], y[1]); hi.y = cvt_pk_bf16(y[2], y[3]); hi.z = cvt_pk_bf16(y[4], y[5]); hi.w = cvt_pk_bf16(y[6], y[7]);
                *(GAS u32x4*)(X1B + row * 2048 + e0) = hi;
                { u32x2 f8; f8.x = pk4_fp8(y[0] * A8_SCALE, y[1] * A8_SCALE, y[2] * A8_SCALE, y[3] * A8_SCALE); f8.y = pk4_fp8(y[4] * A8_SCALE, y[5] * A8_SCALE, y[6] * A8_SCALE, y[7] * A8_SCALE); *(GAS u32x2*)(X1F8 + row * 2048 + e0) = f8; }
                u32x4 lo; lo.x = cvt_pk_bf16(y[0] - bf_lo(hi.x), y[1] - bf_hi(hi.x)); lo.y = cvt_pk_bf16(y[2] - bf_lo(hi.y), y[3] - bf_hi(hi.y)); lo.z = cvt_pk_bf16(y[4] - bf_lo(hi.z), y[5] - bf_hi(hi.z)); lo.w = cvt_pk_bf16(y[6] - bf_lo(hi.w), y[7] - bf_hi(hi.w));
                *(LAS u32x4*)(XH + lr * RT_XSTRIDE + e0 * 2) = hi; *(LAS u32x4*)(XL + lr * RT_XSTRIDE + e0 * 2) = lo; }
        }
        __syncthreads();
        if (grp + F.G < T_TOK / 16) LN1_LOAD(grp + F.G);
        f32x4 acc[3];
#pragma unroll
        for (int t = 0; t < 3; ++t) acc[t] = (f32x4){0.f, 0.f, 0.f, 0.f};
#pragma unroll 4
        for (int s8 = 0; s8 < 8; ++s8) {
            const int kk = 256 * w + 32 * s8 + 8 * (lane >> 4);
            const bf16x8 ah = *(const LAS bf16x8*)(XH + (lane & 15) * RT_XSTRIDE + kk * 2), al = *(const LAS bf16x8*)(XL + (lane & 15) * RT_XSTRIDE + kk * 2);
#pragma unroll
            for (int t = 0; t < 3; ++t) { const bf16_t* wb = WR + s8 * RT_WBLK + (t < 2 ? t * 1024 : l2);
                const bf16x8 bh = *(const GAS bf16x8*)wb, bl = *(const GAS bf16x8*)(wb + (t < 2 ? 512 : 128));
                acc[t] = __builtin_amdgcn_mfma_f32_16x16x32_bf16(ah, bh, acc[t], 0, 0, 0); acc[t] = __builtin_amdgcn_mfma_f32_16x16x32_bf16(al, bh, acc[t], 0, 0, 0); acc[t] = __builtin_amdgcn_mfma_f32_16x16x32_bf16(ah, bl, acc[t], 0, 0, 0); }
        }
        __syncthreads();
#pragma unroll
        for (int t = 0; t < 3; ++t) red[(w * 3 + t) * 64 + lane] = acc[t];
        __syncthreads();
        for (int idx = tid; idx < 16 * 36; idx += NTHREADS) { const int row = idx / 36, n = idx % 36, t = n >> 4, sl = (row >> 2) * 16 + (n & 15), rg = row & 3;
            float s = 0.f;
#pragma unroll
            for (int ww = 0; ww < 8; ++ww) s += ((const LAS float*)&red[(ww * 3 + t) * 64 + sl])[rg];
            lg[row * 48 + n] = s + bias[n]; }
        __syncthreads();
        if (tid < 16) {
            const LAS float* L = lg + tid * 48; const int tok = grp * 16 + tid;
            int gi = 0; float gm = L[0];
#pragma unroll
            for (int i = 1; i < 4; ++i) if (L[i] > gm) { gm = L[i]; gi = i; }
            float gs = 0.f;
#pragma unroll
            for (int i = 0; i < 4; ++i) gs += expf(L[i] - gm);
            const float pg = 1.0f / gs;
            const LAS float* E = L + 4 + gi * 8;
            int e1 = 0; float l1 = E[0];
#pragma unroll
            for (int i = 1; i < 8; ++i) if (E[i] > l1) { l1 = E[i]; e1 = i; }
            int e2 = -1; float l2 = -INFINITY;
#pragma unroll
            for (int i = 0; i < 8; ++i) if (i != e1 && E[i] > l2) { l2 = E[i]; e2 = i; }
            const float r = expf(l2 - l1), g1 = pg / (1.0f + r), g2 = pg * r / (1.0f + r);
            const int ea = gi * 8 + e1, eb = gi * 8 + e2;
            const unsigned pa = atomicAdd(cnt + 64 * ea, 1u); const unsigned pb = atomicAdd(cnt + 64 * eb, 1u);
            TL[(size_t)ea * TL_CAP + pa] = tok * 2; TL[(size_t)eb * TL_CAP + pb] = tok * 2 + 1;
            GWp[(size_t)ea * TL_CAP + pa] = g1; GWp[(size_t)eb * TL_CAP + pb] = g2;
        }
    }
}

__device__ __forceinline__ void ln2_phase(Frame& F, const Args& args) {
    const int lane = F.lane, gw = F.vcu * NWAVES + F.wave, NGW = F.G * NWAVES;
    const bf16_t* Y = (const bf16_t*)(F.ws + Z_Y); const bf16_t* XB = (const bf16_t*)(F.ws + S2_X1B); bf16_t* XO = (bf16_t*)(F.ws + S2_X2B); unsigned char* X2F8 = F.ws + Z_X2F8;
    LAS float* gbl = (LAS float*)F.lds;
    { *(LAS f32x4*)(gbl + 4 * F.tid) = *(const f32x4*)(args.in[I_LN2G] + 4 * F.tid); *(LAS f32x4*)(gbl + 2048 + 4 * F.tid) = *(const f32x4*)(args.in[I_LN2B] + 4 * F.tid); }
    u32x4 qa[2][4], q0[2][4], q1[2][4];
#define LN2_LOAD(RP_) do { _Pragma("unroll") for (int rr = 0; rr < 2; ++rr) { const size_t row_ = (size_t)(RP_) * 2 + rr; _Pragma("unroll") for (int i = 0; i < 4; ++i) { const int e0 = i * 512 + lane * 8; \
        qa[rr][i] = *(const GAS u32x4*)(XB + row_ * 2048 + e0); q0[rr][i] = *(const GAS u32x4*)(Y + (2 * row_) * 2048 + e0); q1[rr][i] = *(const GAS u32x4*)(Y + (2 * row_ + 1) * 2048 + e0); } } } while (0)
    if (gw < T_TOK / 2) LN2_LOAD(gw);
    __syncthreads();
    for (int rp = gw; rp < T_TOK / 2; rp += NGW) {
        float v[2][32];
#pragma unroll
        for (int rr = 0; rr < 2; ++rr)
#pragma unroll
            for (int i = 0; i < 4; ++i) { const u32x4 a = qa[rr][i], y0 = q0[rr][i], y1 = q1[rr][i];
                v[rr][8 * i + 0] = ALPHA * bf_lo(a.x) + bf_lo(y0.x) + bf_lo(y1.x); v[rr][8 * i + 1] = ALPHA * bf_hi(a.x) + bf_hi(y0.x) + bf_hi(y1.x); v[rr][8 * i + 2] = ALPHA * bf_lo(a.y) + bf_lo(y0.y) + bf_lo(y1.y); v[rr][8 * i + 3] = ALPHA * bf_hi(a.y) + bf_hi(y0.y) + bf_hi(y1.y);
                v[rr][8 * i + 4] = ALPHA * bf_lo(a.z) + bf_lo(y0.z) + bf_lo(y1.z); v[rr][8 * i + 5] = ALPHA * bf_hi(a.z) + bf_hi(y0.z) + bf_hi(y1.z); v[rr][8 * i + 6] = ALPHA * bf_lo(a.w) + bf_lo(y0.w) + bf_lo(y1.w); v[rr][8 * i + 7] = ALPHA * bf_hi(a.w) + bf_hi(y0.w) + bf_hi(y1.w); }
        if (rp + NGW < T_TOK / 2) LN2_LOAD(rp + NGW);
#pragma unroll
        for (int rr = 0; rr < 2; ++rr) { const size_t row = (size_t)rp * 2 + rr;
            float s = 0.f;
#pragma unroll
            for (int i = 0; i < 32; ++i) s += v[rr][i];
            const float mean = wave_sum(s) * (1.0f / 2048.0f); float q = 0.f;
#pragma unroll
            for (int i = 0; i < 32; ++i) { v[rr][i] -= mean; q += v[rr][i] * v[rr][i]; }
            const float rstd = 1.0f / sqrtf(wave_sum(q) * (1.0f / 2048.0f) + LN_EPS);
#pragma unroll
            for (int i = 0; i < 4; ++i) { const int e0 = i * 512 + lane * 8; float y[8];
                const f32x4 g0 = *(const LAS f32x4*)(gbl + e0), g1 = *(const LAS f32x4*)(gbl + e0 + 4), b0 = *(const LAS f32x4*)(gbl + 2048 + e0), b1 = *(const LAS f32x4*)(gbl + 2048 + e0 + 4);
                y[0] = v[rr][8 * i + 0] * rstd * g0.x + b0.x; y[1] = v[rr][8 * i + 1] * rstd * g0.y + b0.y; y[2] = v[rr][8 * i + 2] * rstd * g0.z + b0.z; y[3] = v[rr][8 * i + 3] * rstd * g0.w + b0.w;
                y[4] = v[rr][8 * i + 4] * rstd * g1.x + b1.x; y[5] = v[rr][8 * i + 5] * rstd * g1.y + b1.y; y[6] = v[rr][8 * i + 6] * rstd * g1.z + b1.z; y[7] = v[rr][8 * i + 7] * rstd * g1.w + b1.w;
                u32x4 hi; hi.x = cvt_pk_bf16(y[0], y[1]); hi.y = cvt_pk_bf16(y[2], y[3]); hi.z = cvt_pk_bf16(y[4], y[5]); hi.w = cvt_pk_bf16(y[6], y[7]);
                *(GAS u32x4*)(XO + tb_off(row, e0, 8)) = hi;
                u32x2 f8; f8.x = pk4_fp8(y[0] * A8_SCALE, y[1] * A8_SCALE, y[2] * A8_SCALE, y[3] * A8_SCALE); f8.y = pk4_fp8(y[4] * A8_SCALE, y[5] * A8_SCALE, y[6] * A8_SCALE, y[7] * A8_SCALE); *(GAS u32x2*)(X2F8 + row * 2048 + e0) = f8; }
        }
    }
}

struct StaticSched {
    static constexpr bool GATHER = false;
    const char* A0; const char* A1; const char* B0; const char* B1; int lda, ldb, nM, nN, nwg, G, c, nseg;
    __device__ __forceinline__ void init(const void* a0, const void* a1, const void* b0, const void* b1, int lda_, int ldb_, int M, int N, int G_, int c_, int nseg_) {
        A0 = (const char*)a0; A1 = (const char*)a1; B0 = (const char*)b0; B1 = (const char*)b1; lda = lda_; ldb = ldb_; nM = M / 256; nN = N / 256; nwg = nM * nN; G = G_; c = c_; nseg = nseg_; }
    __device__ __forceinline__ bool next(int i, pg8::Unit& u) const {
        const int base = (nseg == 2) ? (i >> 1) : i; const long L = (long)base * G + c; if (L >= nwg) return false;
        const int wgid = pg8::xcd_remap((int)L, nwg); pg8::tile_of(wgid, nM, nN, u.pm, u.pn); u.seg = (nseg == 2) ? (i & 1) : 0; u.aux = 0; return true; }
    __device__ __forceinline__ const char* abase(const pg8::Unit& u) const { return (u.seg ? A1 : A0) + (size_t)u.pm * 256 * lda * 2; }
    __device__ __forceinline__ const char* bbase(const pg8::Unit& u) const { return (u.seg ? B1 : B0) + (size_t)u.pn * (ldb / 64) * 32768; }
    __device__ __forceinline__ void gather(const pg8::Unit&, const int (&)[2], const int (&)[2], unsigned (&)[2][2]) const {}
};
struct ZSched {
    static constexpr bool GATHER = false;
    const char* A; const char* B; int lda, ldb, nN, nwg, G, c; unsigned mask;
    __device__ __forceinline__ void init(const void* a, const void* b, int lda_, int ldb_, unsigned mask_, int G_, int c_) { A = (const char*)a; B = (const char*)b; lda = lda_; ldb = ldb_; mask = mask_; nN = __builtin_popcount(mask_); nwg = 64 * nN; G = G_; c = c_; }
    __device__ __forceinline__ bool next(int i, pg8::Unit& u) const {
        const long L = (long)i * G + c; if (L >= nwg) return false;
        const int wgid = pg8::xcd_remap((int)L, nwg); int pn; pg8::tile_of(wgid, 64, nN, u.pm, pn);
        unsigned m = mask; for (int k = 0; k < pn; ++k) m &= m - 1;
        u.pn = __builtin_ctz(m); u.seg = 0; u.aux = 0; return true; }
    __device__ __forceinline__ const char* abase(const pg8::Unit& u) const { return A + (size_t)u.pm * 256 * lda * 2; }
    __device__ __forceinline__ const char* bbase(const pg8::Unit& u) const { return B + (size_t)u.pn * (ldb / 64) * 32768; }
    __device__ __forceinline__ void gather(const pg8::Unit&, const int (&)[2], const int (&)[2], unsigned (&)[2][2]) const {}
};
constexpr int LDS_TAB_OFF = RING_BYTES;
template <bool GATHER_>
struct MoeSched {
    static constexpr bool GATHER = GATHER_;
    const LAS int* tstart; const LAS int* cntl; const char* Abase; const char* Bbase; const int* TL; size_t estride; int lda, ldb, NT, nwg, G, c;
    __device__ __forceinline__ bool next(int i, pg8::Unit& u) const {
        const long L = (long)i * G + c; if (L >= nwg) return false;
        const int wgid = pg8::xcd_remap((int)L, nwg); const int rt = wgid / NT; u.pn = wgid % NT; int e = 0;
#pragma unroll
        for (int step = N_EXPERTS / 2; step >= 1; step >>= 1) if (tstart[e + step] <= rt) e += step;
        u.pm = rt; u.aux = e; u.seg = rt - tstart[e]; return true; }
    __device__ __forceinline__ const char* abase(const pg8::Unit& u) const { return GATHER ? Abase : Abase + (size_t)u.pm * 256 * lda * 2; }
    __device__ __forceinline__ const char* bbase(const pg8::Unit& u) const { return Bbase + (size_t)u.aux * estride + (size_t)u.pn * (ldb / 64) * 32768; }
    __device__ __forceinline__ void gather(const pg8::Unit& u, const int (&R)[2], const int (&C)[2], unsigned (&voff)[2][2]) const {
        const int cn = cntl[u.aux];
#pragma unroll
        for (int h = 0; h < 2; ++h)
#pragma unroll
            for (int i = 0; i < 2; ++i) { const int idx = u.seg * 256 + h * 128 + R[i]; const bool live = idx < cn; const int asg = TL[(size_t)u.aux * TL_CAP + (live ? idx : 0)];
                voff[h][i] = (unsigned)((live ? asg : 0) >> 1) * (unsigned)(lda * 2) + (unsigned)C[i] * 2u; } }
};

typedef const f32x4 (&AccRef)[2][2][4][2];
__device__ __forceinline__ size_t gate_off(int pm, int tile, int ai, int m, int wr, int wc, int fr, int fq) { return ((size_t)(pm * 16 + tile) * 8 + (size_t)(ai * 4 + m)) * 8192 + (size_t)(((wr * 4 + wc) * 64 + fq * 16 + fr) * 16); }
__device__ __forceinline__ size_t frag_off(int pm, int tile, int ntile, int ai, int m, int bj, int wr, int wc, int fr, int fq) { return ((size_t)(pm * ntile + tile) * 16 + (size_t)((ai * 4 + m) * 2 + bj)) * 8192 + (size_t)(((wr * 4 + wc) * 64 + fq * 16 + fr) * 16); }
__device__ __forceinline__ f32x4 sig4(const f32x4 v) { return (f32x4){sigmoidf_(v.x), sigmoidf_(v.y), sigmoidf_(v.z), sigmoidf_(v.w)}; }

struct EpiZ {
    static constexpr bool PERM = true; static constexpr bool INPLACE = false; bf16_t* Z; unsigned char* GT; const float* bias; float scale; const LAS float* btab;
    __device__ __forceinline__ void operator()(AccRef acc, const pg8::Unit& u, int wr, int wc, int fr, int fq) const {
        const int row0 = u.pm * 256 + wr * 64 + fr, col0 = u.pn * 256 + wc * 32 + 8 * fq, bcol0 = col0 + (u.pn >= 12 ? 8 : 0);
        const bool sg = (u.pn >= 8 && u.pn < 12) || u.pn >= 16, gt = u.pn >= 16;
        f32x4 bv[2][2];
        if (btab) { const LAS float* bl = btab + __builtin_popcount((unsigned)(Z8_MASK) & ((1u << u.pn) - 1u)) * 256 + wc * 32 + 8 * fq;
#pragma unroll
            for (int bj = 0; bj < 2; ++bj)
#pragma unroll
                for (int n = 0; n < 2; ++n) bv[bj][n] = *(const LAS f32x4*)(bl + bj * 128 + 4 * n); }
        else
#pragma unroll
        for (int bj = 0; bj < 2; ++bj)
#pragma unroll
            for (int n = 0; n < 2; ++n) bv[bj][n] = *(const f32x4*)(bias + bcol0 + bj * 128 + 4 * n);
#pragma unroll
        for (int ai = 0; ai < 2; ++ai)
#pragma unroll
            for (int m = 0; m < 4; ++m) {
                f32x4 v00 = acc[ai][0][m][0] * scale + bv[0][0], v01 = acc[ai][0][m][1] * scale + bv[0][1], v10 = acc[ai][1][m][0] * scale + bv[1][0], v11 = acc[ai][1][m][1] * scale + bv[1][1];
                if (sg) { v00 = sig4(v00); v01 = sig4(v01); v10 = sig4(v10); v11 = sig4(v11); }
                if (gt) { u32x4 q; q.x = pk4_u8(v00); q.y = pk4_u8(v01); q.z = pk4_u8(v10); q.w = pk4_u8(v11); *(GAS u32x4*)(GT + gate_off(u.pm, u.pn - 16, ai, m, wr, wc, fr, fq)) = q; }
                else { bf16_t* rowp = Z + tb_off((size_t)(row0 + ai * 128 + m * 16), col0 & 4095, ZT); *(GAS u32x4*)rowp = pack8(v00, v01); *(GAS u32x4*)(rowp + 128) = pack8(v10, v11); } }
    }
};
struct EpiMerge {
    static constexpr bool PERM = true; static constexpr bool INPLACE = true; const unsigned char* GT; bf16_t* merged;
    typedef f32x4 (&AccMut)[2][2][4][2];
    __device__ __forceinline__ bool first_segment(const pg8::Unit& u) const { return u.seg == 0; }
    __device__ __forceinline__ static f32x4 floor4(const f32x4 v) { return (f32x4){fmaxf(v.x, 1.0f / 512.0f), fmaxf(v.y, 1.0f / 512.0f), fmaxf(v.z, 1.0f / 512.0f), fmaxf(v.w, 1.0f / 512.0f)}; }
    __device__ __forceinline__ static f32x4 rcp4(const f32x4 v) { return (f32x4){__builtin_amdgcn_rcpf(v.x), __builtin_amdgcn_rcpf(v.y), __builtin_amdgcn_rcpf(v.z), __builtin_amdgcn_rcpf(v.w)}; }
    __device__ __forceinline__ void rescale(AccMut acc, const pg8::Unit& u, int wr, int wc, int fr, int fq) const {
        u32x4 gp[2][4], gm[2][4];
#pragma unroll
        for (int ai = 0; ai < 2; ++ai)
#pragma unroll
            for (int m = 0; m < 4; ++m) { gp[ai][m] = *(const GAS u32x4*)(GT + gate_off(u.pm, 8 + u.pn, ai, m, wr, wc, fr, fq)); gm[ai][m] = *(const GAS u32x4*)(GT + gate_off(u.pm, u.pn, ai, m, wr, wc, fr, fq)); }
#pragma unroll
        for (int ai = 0; ai < 2; ++ai)
#pragma unroll
            for (int m = 0; m < 4; ++m)
#pragma unroll
                for (int bj = 0; bj < 2; ++bj) {
                    acc[ai][bj][m][0] = acc[ai][bj][m][0] * (un4_u8(bj ? gp[ai][m].z : gp[ai][m].x) * rcp4(floor4(un4_u8(bj ? gm[ai][m].z : gm[ai][m].x))));
                    acc[ai][bj][m][1] = acc[ai][bj][m][1] * (un4_u8(bj ? gp[ai][m].w : gp[ai][m].y) * rcp4(floor4(un4_u8(bj ? gm[ai][m].w : gm[ai][m].y)))); }
    }
    __device__ __forceinline__ void operator()(AccRef acc, const pg8::Unit& u, int wr, int wc, int fr, int fq) const {
        const int row0 = u.pm * 256 + wr * 64 + fr, col0 = u.pn * 256 + wc * 32 + 8 * fq;
        u32x4 gq[2][4];
#pragma unroll
        for (int ai = 0; ai < 2; ++ai)
#pragma unroll
            for (int m = 0; m < 4; ++m) gq[ai][m] = *(const GAS u32x4*)(GT + gate_off(u.pm, u.pn, ai, m, wr, wc, fr, fq));
#pragma unroll
        for (int ai = 0; ai < 2; ++ai)
#pragma unroll
            for (int m = 0; m < 4; ++m)
#pragma unroll
                for (int bj = 0; bj < 2; ++bj) { const size_t r = (size_t)(row0 + ai * 128 + m * 16); const int c = col0 + bj * 128;
                    const f32x4 v0 = acc[ai][bj][m][0] * floor4(un4_u8(bj ? gq[ai][m].z : gq[ai][m].x)), v1 = acc[ai][bj][m][1] * floor4(un4_u8(bj ? gq[ai][m].w : gq[ai][m].y));
                    *(GAS u32x4*)((unsigned char*)merged + ((size_t)((r >> 8) * 32 + (c >> 6)) * 256 + (r & 255)) * 128 + (c & 63) * 2) = pack8(v0, v1); }
    }
};
struct EpiHpre {
    static constexpr bool PERM = true; static constexpr bool INPLACE = false; bf16_t* out;
    __device__ __forceinline__ void operator()(AccRef acc, const pg8::Unit& u, int wr, int wc, int fr, int fq) const {
        const int row0 = u.pm * 256 + wr * 64 + fr, col0 = u.pn * 256 + wc * 32 + 8 * fq;
#pragma unroll
        for (int ai = 0; ai < 2; ++ai)
#pragma unroll
            for (int m = 0; m < 4; ++m)
#pragma unroll
                for (int bj = 0; bj < 2; ++bj) *(GAS u32x4*)(out + tb_off((size_t)(row0 + ai * 128 + m * 16), col0 + bj * 128, 8)) = pack8(acc[ai][bj][m][0], acc[ai][bj][m][1]);
    }
};
struct EpiHid {
    static constexpr bool PERM = true; static constexpr bool INPLACE = false; unsigned char* hid;
    __device__ __forceinline__ void operator()(AccRef acc, const pg8::Unit& u, int wr, int wc, int fr, int fq) const {
        const int row0 = u.pm * 256 + wr * 64 + fr, col0 = u.pn * 128 + wc * 32 + 8 * fq;
#pragma unroll
        for (int ai = 0; ai < 2; ++ai)
#pragma unroll
            for (int m = 0; m < 4; ++m) { const f32x4 g0 = acc[ai][0][m][0] * INV8, g1 = acc[ai][0][m][1] * INV8;
                const f32x4 v0 = g0 * sig4(g0) * acc[ai][1][m][0] * (INV8 * A8_SCALE), v1 = g1 * sig4(g1) * acc[ai][1][m][1] * (INV8 * A8_SCALE);
                u32x2 o; o.x = pk4_fp8(v0.x, v0.y, v0.z, v0.w); o.y = pk4_fp8(v1.x, v1.y, v1.z, v1.w);
                { const size_t r = (size_t)(row0 + ai * 128 + m * 16); *(GAS u32x2*)(hid + (((r >> 8) * 6 + (size_t)(col0 >> 7)) * 256 + (r & 255)) * 128 + (col0 & 127)) = o; } }
    }
};
struct EpiY {
    static constexpr bool PERM = true; static constexpr bool INPLACE = false; bf16_t* Y; const int* TL; const float* GWp; const LAS int* cntl;
    __device__ __forceinline__ void operator()(AccRef acc, const pg8::Unit& u, int wr, int wc, int fr, int fq) const {
        const int cn = cntl[u.aux], col0 = u.pn * 256 + wc * 32 + 8 * fq;
        int asg[2][4]; float gw[2][4];
#pragma unroll
        for (int ai = 0; ai < 2; ++ai)
#pragma unroll
            for (int m = 0; m < 4; ++m) { const int idx = u.seg * 256 + ai * 128 + wr * 64 + m * 16 + fr; const size_t o = (size_t)u.aux * TL_CAP + (idx < cn ? idx : 0);
                asg[ai][m] = TL[o]; gw[ai][m] = GWp[o]; if (idx >= cn) asg[ai][m] = -1; }
#pragma unroll
        for (int ai = 0; ai < 2; ++ai)
#pragma unroll
            for (int m = 0; m < 4; ++m) { asm volatile("" : "+v"(gw[ai][m])); gw[ai][m] *= INV8; }
#pragma unroll
        for (int ai = 0; ai < 2; ++ai)
#pragma unroll
            for (int m = 0; m < 4; ++m)
                if (asg[ai][m] >= 0) {
#pragma unroll
                    for (int bj = 0; bj < 2; ++bj) *(GAS u32x4*)(Y + (size_t)asg[ai][m] * 2048 + col0 + bj * 128) = pack8(acc[ai][bj][m][0] * gw[ai][m], acc[ai][bj][m][1] * gw[ai][m]); }
    }
};
struct EpiPark {
    static constexpr bool PERM = true; static constexpr bool INPLACE = false; unsigned char* park;
    __device__ __forceinline__ void operator()(AccRef acc, const pg8::Unit& u, int wr, int wc, int fr, int fq) const {
#pragma unroll
        for (int ai = 0; ai < 2; ++ai)
#pragma unroll
            for (int m = 0; m < 4; ++m)
#pragma unroll
                for (int bj = 0; bj < 2; ++bj) *(GAS u32x4*)(park + frag_off(u.pm, u.pn, 8, ai, m, bj, wr, wc, fr, fq)) = pack8(acc[ai][bj][m][0], acc[ai][bj][m][1]);
    }
};
struct EpiOut {
    static constexpr bool PERM = true; static constexpr bool INPLACE = false; const bf16_t* x2; const unsigned char* park; const float* bias; float* out;
    __device__ __forceinline__ void operator()(AccRef acc, const pg8::Unit& u, int wr, int wc, int fr, int fq) const {
        const int row0 = u.pm * 256 + wr * 64 + fr, col0 = u.pn * 256 + wc * 32 + 8 * fq;
        f32x4 bv[2][2];
#pragma unroll
        for (int bj = 0; bj < 2; ++bj)
#pragma unroll
            for (int n = 0; n < 2; ++n) bv[bj][n] = *(const f32x4*)(bias + col0 + bj * 128 + 4 * n);
#pragma unroll
        for (int ai = 0; ai < 2; ++ai) {
            u32x4 pk[4][2], xv[4][2];
#pragma unroll
            for (int m = 0; m < 4; ++m)
#pragma unroll
                for (int bj = 0; bj < 2; ++bj) { const size_t off = (size_t)(row0 + ai * 128 + m * 16) * 2048 + col0 + bj * 128; pk[m][bj] = *(const GAS u32x4*)(park + frag_off(u.pm, u.pn, 8, ai, m, bj, wr, wc, fr, fq)); xv[m][bj] = *(const GAS u32x4*)(x2 + tb_off((size_t)(row0 + ai * 128 + m * 16), col0 + bj * 128, 8)); }
#pragma unroll
            for (int m = 0; m < 4; ++m)
#pragma unroll
                for (int bj = 0; bj < 2; ++bj) { const size_t off = (size_t)(row0 + ai * 128 + m * 16) * 2048 + col0 + bj * 128;
                    *(GAS f32x4*)(out + off) = unpk_lo(xv[m][bj]) + sig4(acc[ai][bj][m][0] * INV8 + bv[bj][0]) * unpk_lo(pk[m][bj]);
                    *(GAS f32x4*)(out + off + 4) = unpk_hi(xv[m][bj]) + sig4(acc[ai][bj][m][1] * INV8 + bv[bj][1]) * unpk_hi(pk[m][bj]); }
            asm volatile("" ::: "memory");
        }
    }
};

struct WeffSched {
    static constexpr bool GATHER = false;
    const char* A; const char* B; int G, c;
    __device__ __forceinline__ bool next(int i, pg8::Unit& u) const { const int L = i * G + c; if (L >= 32) return false; u.pm = L & 7; u.pn = L >> 3; u.seg = 0; u.aux = 0; return true; }
    __device__ __forceinline__ const char* abase(const pg8::Unit& u) const { return A + (size_t)(u.pm * 16 + u.pn * 4) * 32768; }
    __device__ __forceinline__ const char* bbase(const pg8::Unit& u) const { return B + (size_t)(u.pn * 4) * 32768; }
    __device__ __forceinline__ void gather(const pg8::Unit&, const int (&)[2], const int (&)[2], unsigned (&)[2][2]) const {}
};
struct EpiWeff {
    static constexpr bool PERM = true; static constexpr bool INPLACE = false; unsigned char* W;
    __device__ __forceinline__ void operator()(AccRef acc, const pg8::Unit& u, int wr, int wc, int fr, int fq) const {
#pragma unroll
        for (int ai = 0; ai < 2; ++ai)
#pragma unroll
            for (int m = 0; m < 4; ++m)
#pragma unroll
                for (int bj = 0; bj < 2; ++bj) { const int r = ai * 128 + wr * 64 + m * 16 + fr, k = u.pn * 256 + bj * 128 + wc * 32 + 8 * fq;
                    *(GAS u32x4*)(W + ((size_t)(u.pm * 16 + (k >> 6)) * 256 + r) * 128 + (k & 63) * 2) = pack8(acc[ai][bj][m][0], acc[ai][bj][m][1]); }
    }
};
struct ParkSched {
    static constexpr bool GATHER = false;
    const char* A; const char* B; int u0, u1;
    __device__ __forceinline__ void init(const void* a, const void* b, int nheavy, int G, int c, int first) {
        A = (const char*)a; B = (const char*)b; const int nlight = G - nheavy, N = 512 - first;
        int bq = (N - 2 * nlight + G - 1) / G; if (bq < 0) bq = 0; const int aq = bq + 2;
        if (c >= nheavy) { u0 = (c - nheavy) * aq; u1 = u0 + aq; } else { u0 = nlight * aq + c * bq; u1 = u0 + bq; }
        if (u0 > N) u0 = N; if (u1 > N) u1 = N; u0 += first; u1 += first; }
    __device__ __forceinline__ void init_one(const void* a, const void* b, int x) { A = (const char*)a; B = (const char*)b; u0 = x; u1 = x + 1; }
    __device__ __forceinline__ bool next(int i, pg8::Unit& u) const { const int x = u0 + i; if (x >= u1) return false; u.pm = x >> 3; u.pn = x & 7; u.seg = 0; u.aux = 0; return true; }
    __device__ __forceinline__ const char* abase(const pg8::Unit& u) const { return A + (size_t)u.pm * 256 * 256 * 2; }
    __device__ __forceinline__ const char* bbase(const pg8::Unit& u) const { return B + (size_t)u.pn * 4 * 32768; }
    __device__ __forceinline__ void gather(const pg8::Unit&, const int (&)[2], const int (&)[2], unsigned (&)[2][2]) const {}
};
constexpr int N_PHASES = 12;
__global__ void __launch_bounds__(NTHREADS, 2) mk_fwd(Args args) {
    extern __shared__ __attribute__((aligned(16))) unsigned char lds_raw[];
    Frame F;
    F.lds = (LAS unsigned char*)lds_raw;
    F.tid = threadIdx.x; F.lane = F.tid & 63; F.wave = __builtin_amdgcn_readfirstlane(F.tid >> 6);
    F.G = gridDim.x; { const int bx = blockIdx.x; F.vcu = (F.G % 8 == 0) ? (bx % 8) * (F.G / 8) + bx / 8 : bx; }
    F.ws = args.ws; F.outb = (unsigned char*)args.out;
    volatile LAS unsigned* MISC = (volatile LAS unsigned*)(F.lds + LDS_MISC_OFF);
    if (F.tid < 64) MISC[F.tid] = 0u;
    __syncthreads();
    unsigned* ctl = (unsigned*)(F.ws + WS_CTL);
    XcdBarrier bar; bar.bar = ctl + CW_BAR; bar.x = 0; bar.st = nullptr;
    if (MK_N_LAUNCHES == 1) bar = xcd_barrier_post(ctl + CW_BAR, MISC + 8);
    const int lo = args.ph_lo, hi = args.ph_hi;
#ifndef PH_MASK
#define PH_MASK 0xFFF
#endif
#define IN(k) ((((PH_MASK) >> (k)) & 1) && lo <= (k) && (k) < hi)
#ifdef PROBE_PH
    unsigned long long pt0 = 0, pt1 = 0;
#define SEAM(k) do { if (IN(k) && IN((k) + 1)) xcd_barrier(bar); if ((k) + 1 == PROBE_PH) pt0 = __builtin_amdgcn_s_memrealtime(); if ((k) == PROBE_PH) pt1 = __builtin_amdgcn_s_memrealtime(); } while (0)
#else
#define SEAM(k) do { if (IN(k) && IN((k) + 1)) xcd_barrier(bar); } while (0)
#endif
    LAS unsigned char* ring = F.lds;
    const int bid = (int)blockIdx.x;

#ifdef PROBE_PH
    if (PROBE_PH == 0) pt0 = __builtin_amdgcn_s_memrealtime();
#endif
    if (IN(0)) { p0_prologue(F, args); } SEAM(0);

    if (IN(1)) {
        if (F.vcu < NBH) gate_scan(F, F.vcu);
        const int mq0 = TSTEPS_P0 + (int)(((long)((TSTEPS - TSTEPS_P0) / 4) * F.vcu) / F.G) * 4, mq1 = TSTEPS_P0 + (int)(((long)((TSTEPS - TSTEPS_P0) / 4) * (F.vcu + 1)) / F.G) * 4;
        const bool conv_first = ((bid >> 3) & 1) != 0;
        if (conv_first) transpose_range(F, args, mq0, mq1);
        LAS float* btab = (LAS float*)(F.lds + RING_BYTES + 512);
        { constexpr int NZ8 = __builtin_popcount((unsigned)(Z8_MASK));
          static_assert(RING_BYTES + 512 + NZ8 * 1024 <= LDS_USABLE, "bias table");
          __syncthreads();
#pragma unroll
          for (int k = 0; k < (NZ8 * 64 + NTHREADS - 1) / NTHREADS; ++k) { const int item = F.tid + k * NTHREADS, slot = item >> 6, q = item & 63, sl = slot < NZ8 ? slot : 0;
              unsigned m = (unsigned)(Z8_MASK); for (int j = 0; j < sl; ++j) m &= m - 1; const int pn = __builtin_ctz(m);
              const f32x4 v = *(const f32x4*)(args.in[I_BIN] + pn * 256 + (pn >= 12 ? 8 : 0) + 4 * q);
              if (slot < NZ8) *(LAS f32x4*)(btab + slot * 256 + 4 * q) = v; }
          __syncthreads(); }
#pragma unroll 1
        for (int pass = 0; pass < 2; ++pass) {
            if ((pass ^ (bid & 1)) == 0) { ZSched S; S.init(F.outb + OUT_XB, F.ws + W_IN, 2048, 2048, ~(unsigned)(Z8_MASK), F.G, bid);
                EpiZ E{(bf16_t*)(F.ws + WS_Z), F.ws + WS_GT, args.in[I_BIN], 1.0f, nullptr};
                pg8::gemm_phase<EpiZ, ZSched>(ring, 2048, 2048, 2048, S, E); }
            else if ((unsigned)(Z8_MASK) != 0u) { ZSched S; S.init(F.ws + WS_XF8, F.ws + W_IN8, 1024, 1024, (unsigned)(Z8_MASK), F.G, bid);
                EpiZ E{(bf16_t*)(F.ws + WS_Z), F.ws + WS_GT, args.in[I_BIN], INV8, btab};
                pg8::gemm_phase<EpiZ, ZSched, true>(ring, 1024, 1024, 1024, S, E); }
        }
        if (!conv_first) transpose_range(F, args, mq0, mq1);
    } SEAM(1);

    if (IN(2)) {
        const bool pool_first = (bid & 1) != 0;
        if (pool_first) pool_phase(F);
        for (int u = F.vcu; u < NBH * NCHUNK; u += F.G) mlstm_m1_unit(F, args, u >> 5, u & 31);
        if (!pool_first) pool_phase(F);
    } SEAM(2);

    if (IN(3)) {
        const bool weff = bid < 32 && F.G >= 64;
        if (weff || F.G < 64) { if (bid < 32) { WeffSched S; S.A = (const char*)(F.ws + W_PBRT); S.B = (const char*)(F.ws + W_PS); S.G = F.G < 32 ? F.G : 32; S.c = bid;
            EpiWeff E{F.ws + W_EFF};
            pg8::gemm_phase<EpiWeff, WeffSched, false, true>(ring, 256, 256, 256, S, E); } }
        const int np3 = F.G - 32 - NSCAN_MIN > 0 ? F.G - 32 - NSCAN_MIN : 0;
        const bool parker = F.G >= 64 && bid >= 32 && bid < 32 + np3;
        if (parker) { ParkSched P; P.init_one(F.ws + WS_PB, F.ws + W_PP, bid - 32); EpiPark EP{F.ws + S2_PARK2}; pg8::gemm_phase<EpiPark, ParkSched>(ring, 256, 256, 256, P, EP); }
        if (!weff && !parker) mlstm_m2(F, F.G >= 64 ? bid - 32 - np3 : bid, F.G >= 64 ? F.G - 32 - np3 : F.G);
    } SEAM(3);

    if (IN(4)) { for (int u = F.vcu; u < NBH * NCHUNK; u += F.G) mlstm_m3_unit(F, args, u >> 5, u & 31); } SEAM(4);

    if (IN(5)) {
        StaticSched S; S.init(F.outb + OUT_PU, F.outb + OUT_HG, F.ws + W_EFF, F.ws + W_MBR, 1024, 1024, T_TOK, 2048, F.G, bid, 2);
        EpiMerge E{F.ws + WS_GT, (bf16_t*)(F.ws + S2_MERGED)};
        pg8::gemm_phase<EpiMerge, StaticSched, false, true>(ring, 1024, 1024, 1024, S, E);
    } SEAM(5);

    if (IN(6)) {
        StaticSched S; S.init(F.ws + S2_MERGED, nullptr, F.ws + W_OUT, nullptr, 2048, 2048, T_TOK, 2048, F.G, bid, 1);
        EpiHpre E{(bf16_t*)(F.ws + Z_X1)};
        pg8::gemm_phase<EpiHpre, StaticSched, false, true>(ring, 2048, 2048, 2048, S, E);
    } SEAM(6);

    if (IN(7)) { ln1_router_phase(F, args); } SEAM(7);

    if (IN(8) || IN(9)) {
        LAS int* tstart = (LAS int*)(F.lds + LDS_TAB_OFF); LAS int* cntl = (LAS int*)(F.lds + LDS_TAB_OFF + 256);
        if (F.tid < N_EXPERTS) cntl[F.tid] = (int)__hip_atomic_load(ctl + CW_CNT + 64 * F.tid, RLX_AGENT);
        __syncthreads();
        if (F.tid == 0) { int s = 0; for (int e = 0; e < N_EXPERTS; ++e) { tstart[e] = s; s += (cntl[e] + 255) >> 8; } tstart[N_EXPERTS] = s; }
        __syncthreads();
        const int RT = tstart[N_EXPERTS];
        if (IN(8)) {
            MoeSched<true> S; S.tstart = tstart; S.cntl = cntl; S.Abase = (const char*)(F.ws + S2_X1F8); S.Bbase = (const char*)(F.ws + W_GU); S.TL = (const int*)(F.ws + WS_SMALL + SM_TL);
            S.estride = (size_t)1536 * 2048; S.lda = 1024; S.ldb = 1024; S.NT = 6; S.nwg = RT * 6; S.G = F.G; S.c = bid;
            EpiHid E{F.ws + S2_HID};
            pg8::gemm_phase<EpiHid, MoeSched<true>, true>(ring, 1024, 1024, 1024, S, E);
            { ParkSched P; P.init(F.ws + WS_PB, F.ws + W_PP, (RT * 6) % F.G, F.G, bid, F.G >= 64 && F.G - 32 - NSCAN_MIN > 0 ? F.G - 32 - NSCAN_MIN : 0);
              EpiPark EP{F.ws + S2_PARK2};
              pg8::gemm_phase<EpiPark, ParkSched>(ring, 256, 256, 256, P, EP); }
        }
        SEAM(8);
        if (IN(9)) {
            MoeSched<false> S; S.tstart = tstart; S.cntl = cntl; S.Abase = (const char*)(F.ws + S2_HID); S.Bbase = (const char*)(F.ws + W_DN); S.TL = (const int*)(F.ws + WS_SMALL + SM_TL);
            S.estride = (size_t)2048 * 768; S.lda = 384; S.ldb = 384; S.NT = 8; S.nwg = RT * 8; S.G = F.G; S.c = bid;
            EpiY E{(bf16_t*)(F.ws + Z_Y), (const int*)(F.ws + WS_SMALL + SM_TL), (const float*)(F.ws + WS_SMALL + SM_GW), cntl};
            pg8::gemm_phase<EpiY, MoeSched<false>, true, true>(ring, 384, 384, 384, S, E);
        }
    } SEAM(9);

    if (IN(10)) { ln2_phase(F, args); } SEAM(10);

    if (IN(11)) {
        { StaticSched S; S.init(F.ws + Z_X2F8, nullptr, F.ws + W_PG8, nullptr, 1024, 1024, T_TOK, 2048, F.G, bid, 1);
          EpiOut E{(const bf16_t*)(F.ws + S2_X2B), F.ws + S2_PARK2, args.in[I_BPG], args.out};
          pg8::gemm_phase<EpiOut, StaticSched, true>(ring, 1024, 1024, 1024, S, E); }
    }
#ifdef PROBE_PH
    { if (PROBE_PH == 0) pt0 = pt0 ? pt0 : 0; if (PROBE_PH == N_PHASES - 1) pt1 = __builtin_amdgcn_s_memrealtime();
      if (blockIdx.x == 0 && F.tid == 0) { const unsigned long long t2 = __builtin_amdgcn_s_memrealtime(); const unsigned long long w = (pt1 - pt0) * PROBE_MULT; while (__builtin_amdgcn_s_memrealtime() - t2 < w) __builtin_amdgcn_s_sleep(8); } }
#endif
#undef IN
#undef SEAM
}

extern "C" void kernel_launch(void* const* d_in, const int* in_sizes, int n_in, void* d_out, int out_size, void* d_ws, size_t ws_size, hipStream_t stream) {
    static int grid = 0;
    if (grid == 0) {
        if (n_in != 26 || in_sizes[0] != T_TOK * D_MODEL || out_size != T_TOK * D_MODEL || ws_size < WS_END) { fprintf(stderr, "kernel_launch: unexpected shapes (n_in %d, ws %zu)\n", n_in, ws_size); grid = -1; return; }
        int dev = 0, cus = 0;
        if (hipGetDevice(&dev) != hipSuccess || hipDeviceGetAttribute(&cus, hipDeviceAttributeMultiprocessorCount, dev) != hipSuccess) { grid = -1; return; }
        if (hipFuncSetAttribute((const void*)mk_fwd, hipFuncAttributeMaxDynamicSharedMemorySize, LDS_BYTES) != hipSuccess) { fprintf(stderr, "kernel_launch: hipFuncSetAttribute failed\n"); grid = -1; return; }
        (void)hipGetLastError();
        grid = cus;
    }
    if (grid < 0) return;
    (void)hipMemsetAsync((char*)d_ws + WS_CTL, 0, CTL_ZERO_BYTES, stream);
    Args a{};
    for (int i = 0; i < 26; ++i) a.in[i] = (const float*)d_in[i];
    a.out = (float*)d_out; a.ws = (unsigned char*)d_ws;
    if (MK_N_LAUNCHES == 1) { a.ph_lo = 0; a.ph_hi = N_PHASES; hipLaunchKernelGGL(mk_fwd, dim3(grid), dim3(NTHREADS), LDS_BYTES, stream, a); }
    else for (int li = 0; li < N_PHASES; ++li) { a.ph_lo = li; a.ph_hi = li + 1; hipLaunchKernelGGL(mk_fwd, dim3(grid), dim3(NTHREADS), LDS_BYTES, stream, a);
#ifdef PROBE_DUP
        if ((PROBE_DUP >> li) & 1) hipLaunchKernelGGL(mk_fwd, dim3(grid), dim3(NTHREADS), LDS_BYTES, stream, a);
#endif
    }
}
```
